# Optimizing an MI355X kernel written in HIP

```python
import math
import jax, jax.numpy as jnp
from jax import lax
import numpy as np

D_MODEL = 2048
BATCH = 4
SEQ = 4096
DEPTH = 4
DEC_BATCH = 1
DEC_SEQ = 8192
PAST_LEN = 128

HEAD_DIM = 64
A_HEADS = 8
A_KV = 2
A_HALF_WIN = 128
B_HEADS = 8
B_PATTERNS = ((128, 1), (512, 4), (2048, 16))
C_HEADS = 4
C_VDIM = 2 * HEAD_DIM
D_HEADS = 8
D_KV = 2
GRID_W = 64
ROPE_THETA = 10000.0
ROPE_PAIRS = HEAD_DIM // 4
QBLK = 128
NUM_BUCKETS = 32
RELPOS_MAX_DIST = 1024
N_BIAS_HEADS = A_HEADS + B_HEADS + C_HEADS
FF_DIM = -(-8 * D_MODEL // (3 * 256)) * 256
N_MOD = 6

SPLIT_SIZES = (
    A_HEADS * HEAD_DIM, A_KV * HEAD_DIM, A_KV * HEAD_DIM,
    B_HEADS * HEAD_DIM, B_HEADS * HEAD_DIM, B_HEADS * HEAD_DIM,
    C_HEADS * 2 * HEAD_DIM, C_HEADS * 2 * HEAD_DIM, C_HEADS * C_VDIM,
    D_HEADS * HEAD_DIM, D_KV * HEAD_DIM, D_KV * HEAD_DIM,
)
IN_WIDTH = sum(SPLIT_SIZES)
MIX_WIDTH = A_HEADS * HEAD_DIM + B_HEADS * HEAD_DIM + C_HEADS * C_VDIM + D_HEADS * HEAD_DIM
NEG_INF = -1e30

kernel_name = "hybrid_parallel_head_group_encoder"


def rms_norm(x, g, eps=1e-6):
    xf = x.astype(jnp.float32)
    y = xf * lax.rsqrt(jnp.mean(xf * xf, axis=-1, keepdims=True) + eps)
    return (y * g.astype(jnp.float32)).astype(x.dtype)


def relpos_bucket(rel):
    half = NUM_BUCKETS // 2
    max_exact = half // 2
    n = jnp.abs(rel)
    nf = jnp.maximum(n, 1).astype(jnp.float32)
    large = max_exact + (jnp.log(nf / max_exact) / math.log(RELPOS_MAX_DIST / max_exact)
                         * (half - max_exact)).astype(jnp.int32)
    large = jnp.minimum(large, half - 1)
    return jnp.where(rel > 0, half, 0) + jnp.where(n < max_exact, n, large)


def relpos_bias(table, rel):
    return jnp.moveaxis(table[relpos_bucket(rel)].astype(jnp.float32), -1, 0)


def banded_attention(q, k, v, half_win, stride, bias_tab, sink=None):
    N, L, KV, G, d = q.shape
    blk = half_win
    nb = -(-L // blk)
    pad = nb * blk - L
    qb = jnp.pad(q, ((0, 0), (0, pad), (0, 0), (0, 0), (0, 0))).reshape(N, nb, blk, KV, G, d)

    def windows(t):
        tp = jnp.pad(t, ((0, 0), (blk, blk + pad), (0, 0), (0, 0))).reshape(N, nb + 2, blk, KV, t.shape[-1])
        return jnp.concatenate([tp[:, :-2], tp[:, 1:-1], tp[:, 2:]], axis=2)

    kw, vw = windows(k), windows(v)
    rel = jnp.arange(3 * blk)[None, :] - blk - jnp.arange(blk)[:, None]
    kpos = (jnp.arange(nb) * blk)[:, None, None] + jnp.arange(blk)[None, :, None] + rel[None]
    valid = (jnp.abs(rel) <= half_win)[None] & (kpos >= 0) & (kpos < L)
    bias = relpos_bias(bias_tab, rel * stride).reshape(KV, G, blk, 3 * blk)
    s = jnp.einsum('nbqhgd,nbkhd->nbhgqk', qb, kw, preferred_element_type=jnp.float32) * (d ** -0.5)
    s = jnp.where(valid[None, :, None, None], s + bias, NEG_INF)
    m = jnp.max(s, axis=-1, keepdims=True)
    if sink is not None:
        sk = sink.astype(jnp.float32).reshape(1, 1, KV, G, 1, 1)
        m = jnp.maximum(m, sk)
    p = jnp.exp(s - m)
    denom = jnp.sum(p, axis=-1, keepdims=True)
    if sink is not None:
        denom = denom + jnp.exp(sk - m)
    o = jnp.einsum('nbhgqk,nbkhe->nbqhge', (p / denom).astype(v.dtype), vw)
    lse = jnp.moveaxis((m + jnp.log(denom))[..., 0], -1, 2)
    o = o.reshape(N, nb * blk, KV, G, -1)[:, :L]
    lse = lse.reshape(N, nb * blk, KV, G)[:, :L]
    return o, lse


def to_strided(t, r):
    B, T = t.shape[:2]
    t = t.reshape(B, T // r, r, *t.shape[2:])
    return jnp.swapaxes(t, 1, 2).reshape(B * r, T // r, *t.shape[3:])


def from_strided(t, B):
    N, L = t.shape[:2]
    r = N // B
    t = t.reshape(B, r, L, *t.shape[2:])
    return jnp.swapaxes(t, 1, 2).reshape(B, L * r, *t.shape[3:])


def dilated_mixture(q, k, v, bias_tab):
    B = q.shape[0]
    outs, lses = [], []
    for window, r in B_PATTERNS:
        o, lse = banded_attention(to_strided(q, r)[:, :, :, None], to_strided(k, r), to_strided(v, r),
                                  window // (2 * r), r, bias_tab)
        outs.append(from_strided(o[:, :, :, 0], B))
        lses.append(from_strided(lse[..., 0], B))
    w = jax.nn.softmax(jnp.stack(lses), axis=0)
    out = jnp.einsum('pbth,pbthd->bthd', w, jnp.stack(outs).astype(jnp.float32))
    return out.astype(q.dtype)


def diff_attention(q, k, v, lam, bias_tab, subln_g, lam_init):
    B, T, H, _, d = q.shape
    nb = T // QBLK
    qb = jnp.moveaxis(q.reshape(B, nb, QBLK, H, 2, d), 1, 0)
    kpos = jnp.arange(T)

    def block(args):
        qblk, i = args
        rel = kpos[None, :] - (i * QBLK + jnp.arange(QBLK))[:, None]
        bias = relpos_bias(bias_tab, rel)
        s = jnp.einsum('bqhmd,bkhmd->bhmqk', qblk, k, preferred_element_type=jnp.float32) * (d ** -0.5)
        p = jax.nn.softmax(s + bias[None, :, None], axis=-1)
        a = p[:, :, 0] - lam * p[:, :, 1]
        return jnp.einsum('bhqk,bkhe->bqhe', a.astype(v.dtype), v)

    o = lax.map(block, (qb, jnp.arange(nb)))
    o = jnp.moveaxis(o, 0, 1).reshape(B, T, H, -1)
    return rms_norm(o, subln_g) * (1.0 - lam_init)


def dense_gqa(q, k, v):
    B, T, KV, G, d = q.shape
    nb = T // QBLK
    qb = jnp.moveaxis(q.reshape(B, nb, QBLK, KV, G, d), 1, 0)

    def block(qblk):
        s = jnp.einsum('bqhgd,bkhd->bhgqk', qblk, k, preferred_element_type=jnp.float32) * (d ** -0.5)
        p = jax.nn.softmax(s, axis=-1)
        return jnp.einsum('bhgqk,bkhd->bqhgd', p.astype(v.dtype), v)

    o = lax.map(block, qb)
    return jnp.moveaxis(o, 0, 1).reshape(B, T, KV * G * d)


def axial_rope_tables(T):
    rows = T // GRID_W
    r_idx, c_idx = jnp.meshgrid(jnp.arange(rows), jnp.arange(GRID_W), indexing='ij')
    pos = jnp.stack([r_idx.reshape(-1), c_idx.reshape(-1)], axis=-1).astype(jnp.float32)
    inv_freq = ROPE_THETA ** (-jnp.arange(ROPE_PAIRS, dtype=jnp.float32) / ROPE_PAIRS)
    ang = pos[:, :, None] * inv_freq
    return jnp.cos(ang), jnp.sin(ang)


def apply_axial_rope(x, cos, sin):
    xf = x.astype(jnp.float32).reshape(*x.shape[:-1], 2, 2, ROPE_PAIRS)
    x1, x2 = xf[..., 0, :], xf[..., 1, :]
    c, s = cos[:, None], sin[:, None]
    out = jnp.stack([x1 * c - x2 * s, x2 * c + x1 * s], axis=-2)
    return out.reshape(x.shape).astype(x.dtype)


def encoder_trunk(x, c, w_mod, b_mod, norm_mix, norm_ffn, w_in, w_out, qk_gain, sink_a,
                  relpos_table, diff_lambda, diff_subln, w_gate_up, w_down):
    B, T, _ = x.shape
    cos, sin = axial_rope_tables(T)
    tab_a = relpos_table[:, :A_HEADS]
    tab_b = relpos_table[:, A_HEADS:A_HEADS + B_HEADS]
    tab_c = relpos_table[:, A_HEADS + B_HEADS:]
    split_at = [int(i) for i in np.cumsum(SPLIT_SIZES)[:-1]]
    for l in range(DEPTH):
        mod = (jax.nn.silu(c) @ w_mod[l] + b_mod[l]).reshape(B, N_MOD, D_MODEL)[:, :, None, :]
        shift_m, scale_m, gate_m, shift_f, scale_f, gate_f = [mod[:, j] for j in range(N_MOD)]
        h = rms_norm(x, norm_mix[l]) * (1 + scale_m) + shift_m
        (qa, ka, va, qb, kb, vb, qc, kc, vc, qd, kd, vd) = jnp.split(h @ w_in[l], split_at, axis=-1)

        qa = rms_norm(qa.reshape(B, T, A_HEADS, HEAD_DIM), qk_gain[l, 0, 0]).reshape(
            B, T, A_KV, A_HEADS // A_KV, HEAD_DIM)
        ka = rms_norm(ka.reshape(B, T, A_KV, HEAD_DIM), qk_gain[l, 0, 1])
        out_a, _ = banded_attention(qa, ka, va.reshape(B, T, A_KV, HEAD_DIM), A_HALF_WIN, 1, tab_a,
                                    sink_a[l].reshape(A_KV, A_HEADS // A_KV))
        out_a = out_a.reshape(B, T, A_HEADS * HEAD_DIM)

        qb = rms_norm(qb.reshape(B, T, B_HEADS, HEAD_DIM), qk_gain[l, 1, 0])
        kb = rms_norm(kb.reshape(B, T, B_HEADS, HEAD_DIM), qk_gain[l, 1, 1])
        out_b = dilated_mixture(qb, kb, vb.reshape(B, T, B_HEADS, HEAD_DIM), tab_b).reshape(
            B, T, B_HEADS * HEAD_DIM)

        lam_init = 0.8 - 0.6 * math.exp(-0.3 * l)
        lv = diff_lambda[l].astype(jnp.float32)
        lam = jnp.exp(jnp.sum(lv[0] * lv[1])) - jnp.exp(jnp.sum(lv[2] * lv[3])) + lam_init
        qc = rms_norm(qc.reshape(B, T, C_HEADS, 2, HEAD_DIM), qk_gain[l, 2, 0])
        kc = rms_norm(kc.reshape(B, T, C_HEADS, 2, HEAD_DIM), qk_gain[l, 2, 1])
        out_c = diff_attention(qc, kc, vc.reshape(B, T, C_HEADS, C_VDIM), lam, tab_c, diff_subln[l],
                               lam_init).reshape(B, T, C_HEADS * C_VDIM)

        qd = apply_axial_rope(rms_norm(qd.reshape(B, T, D_HEADS, HEAD_DIM), qk_gain[l, 3, 0]), cos, sin)
        kd = apply_axial_rope(rms_norm(kd.reshape(B, T, D_KV, HEAD_DIM), qk_gain[l, 3, 1]), cos, sin)
        out_d = dense_gqa(qd.reshape(B, T, D_KV, D_HEADS // D_KV, HEAD_DIM), kd,
                          vd.reshape(B, T, D_KV, HEAD_DIM))

        mix = jnp.concatenate([out_a, out_b, out_c, out_d], axis=-1) @ w_out[l]
        x = x + gate_m * mix

        h = rms_norm(x, norm_ffn[l]) * (1 + scale_f) + shift_f
        g, u = jnp.split(h @ w_gate_up[l], 2, axis=-1)
        x = x + gate_f * ((jax.nn.silu(g) * u) @ w_down[l])
    return x


def setup_inputs(seed: int = 0) -> dict:
    key = jax.random.key(seed)
    ks = jax.random.split(key, 18)

    def nrm(k, shape, s):
        return jax.random.normal(k, shape, jnp.float32) * s

    b_mod = nrm(ks[5], (DEPTH, N_MOD, D_MODEL), 0.02)
    b_mod = b_mod.at[:, 2].add(1.0).at[:, 5].add(1.0).reshape(DEPTH, N_MOD * D_MODEL)
    return {
        "x_prompt": nrm(ks[0], (BATCH, SEQ, D_MODEL), 1.0),
        "x_sample": nrm(ks[1], (DEC_BATCH, DEC_SEQ, D_MODEL), 1.0),
        "c_prompt": nrm(ks[2], (BATCH, D_MODEL), 1.0),
        "c_sample": nrm(ks[3], (DEC_BATCH, D_MODEL), 1.0),
        "w_mod": nrm(ks[4], (DEPTH, D_MODEL, N_MOD * D_MODEL), 0.2 * D_MODEL ** -0.5),
        "b_mod": b_mod,
        "norm_mix": 1.0 + nrm(ks[6], (DEPTH, D_MODEL), 0.02),
        "norm_ffn": 1.0 + nrm(ks[7], (DEPTH, D_MODEL), 0.02),
        "w_in": nrm(ks[8], (DEPTH, D_MODEL, IN_WIDTH), D_MODEL ** -0.5),
        "w_out": nrm(ks[9], (DEPTH, MIX_WIDTH, D_MODEL), MIX_WIDTH ** -0.5),
        "qk_gain": 1.0 + nrm(ks[10], (DEPTH, 4, 2, HEAD_DIM), 0.02),
        "sink_a": nrm(ks[11], (DEPTH, A_HEADS), 0.5),
        "relpos_table": nrm(ks[12], (NUM_BUCKETS, N_BIAS_HEADS), 0.5),
        "diff_lambda": nrm(ks[13], (DEPTH, 4, HEAD_DIM), 0.1),
        "diff_subln": 1.0 + nrm(ks[14], (DEPTH, C_VDIM), 0.02),
        "w_gate_up": nrm(ks[15], (DEPTH, D_MODEL, 2 * FF_DIM), D_MODEL ** -0.5),
        "w_down": nrm(ks[16], (DEPTH, FF_DIM, D_MODEL), FF_DIM ** -0.5),
    }


def reference(x_prompt, x_sample, c_prompt, c_sample, w_mod, b_mod, norm_mix, norm_ffn, w_in, w_out,
              qk_gain, sink_a, relpos_table, diff_lambda, diff_subln, w_gate_up, w_down):
    weights = (w_mod, b_mod, norm_mix, norm_ffn, w_in, w_out, qk_gain, sink_a, relpos_table,
               diff_lambda, diff_subln, w_gate_up, w_down)
    y_prompt = encoder_trunk(x_prompt, c_prompt, *weights)
    y_sample = encoder_trunk(x_sample, c_sample, *weights)
    return (y_prompt, y_sample)
```

```cpp
#include <hip/hip_runtime.h>
#include <cstdio>
#include <cstdint>

#ifndef MK_PER_PHASE
#define MK_PER_PHASE 0
#endif


#ifndef SKIP_PRO
#define SKIP_PRO 0
#endif
#ifndef SKIP_NORM
#define SKIP_NORM 0
#endif
#ifndef SKIP_GIN
#define SKIP_GIN 0
#endif
#ifndef SKIP_ATT
#define SKIP_ATT 0
#endif
#ifndef SKIP_CMB
#define SKIP_CMB 0
#endif
#ifndef SKIP_GOUT
#define SKIP_GOUT 0
#endif
#ifndef SKIP_GGU
#define SKIP_GGU 0
#endif
#ifndef SKIP_GDN
#define SKIP_GDN 0
#endif

#ifndef REP_NORM
#define REP_NORM 1
#endif
#ifndef REP_GIN
#define REP_GIN 1
#endif
#ifndef REP_ATT
#define REP_ATT 1
#endif
#ifndef REP_CMB
#define REP_CMB 1
#endif
#ifndef REP_GRES
#define REP_GRES 1
#endif
#ifndef REP_PRO
#define REP_PRO 1
#endif
#ifndef ATT_REP_MASK
#define ATT_REP_MASK 0
#endif
#ifndef REP_GGU
#define REP_GGU 1
#endif
#define GAS __attribute__((address_space(1)))
#define LAS __attribute__((address_space(3)))
typedef unsigned short bf16;
typedef short bf16x8 __attribute__((ext_vector_type(8)));
typedef short s16x4 __attribute__((ext_vector_type(4)));
typedef float f32x2 __attribute__((ext_vector_type(2)));
typedef float f32x4 __attribute__((ext_vector_type(4)));
typedef float f32x16 __attribute__((ext_vector_type(16)));
typedef unsigned u32x2 __attribute__((ext_vector_type(2)));
typedef unsigned u32x4 __attribute__((ext_vector_type(4)));
typedef __bf16 bf16x2_t __attribute__((ext_vector_type(2)));

constexpr int DM = 2048, TP = 4096, TS = 8192, MP = 16384, M = 24576, DEPTH = 4, NSEQ = 5;
constexpr int INW = 4608, FF = 5632, NMOD = 12288;
constexpr int C_QA = 0, C_KA = 512, C_VA = 640, C_QB = 768, C_KB = 1280, C_VB = 1792, C_QC = 2304, C_KC = 2816, C_VC = 3328, C_QD = 3840, C_KD = 4352, C_VD = 4480;
constexpr float LOG2E = 1.4426950408889634f;
constexpr float QSCALE = 0.125f * LOG2E;
constexpr float NEG_BIG = -1e30f, M_INIT = -30000.f;

constexpr size_t MiB = 1u << 20;
constexpr size_t WS_CTL = 0, CTL_ZERO_BYTES = 64 * 1024;
constexpr size_t WS_MOD = 1 * MiB;
constexpr size_t WS_ROPE = 2 * MiB;
constexpr size_t WS_WIN = 4 * MiB;
constexpr size_t WS_WOUT = 76 * MiB;
constexpr size_t WS_WGU = 108 * MiB;
constexpr size_t WS_WDN = 284 * MiB;
constexpr size_t WS_H = 372 * MiB;
constexpr size_t WS_QKV = 468 * MiB;
constexpr size_t WS_MIX = 684 * MiB;
constexpr size_t WS_BSC = 780 * MiB;
constexpr size_t WS_BLSE = 852 * MiB;
constexpr size_t WS_CSC = 855 * MiB;
constexpr size_t WS_XB = 903 * MiB;
constexpr size_t WS_ACT = 999 * MiB;
constexpr size_t WS_END = 1263 * MiB;
constexpr int CW_BAR = 1024;

constexpr int RING_BYTES = 131072;
constexpr int MISC_OFF = RING_BYTES;
constexpr int LDS_BYTES = 147456;

__device__ __forceinline__ unsigned cvtpk(float lo, float hi) { f32x2 v = {lo, hi}; bf16x2_t b = __builtin_convertvector(v, bf16x2_t); return __builtin_bit_cast(unsigned, b); }
__device__ __forceinline__ float wave_sum(float v) {
#pragma unroll
    for (int o = 1; o < 64; o <<= 1) v += __shfl_xor(v, o);
    return v;
}
__device__ __forceinline__ int seq_of_row(int r) { return r < MP ? (r >> 12) : 4; }
__device__ __forceinline__ int pos_of_row(int r) { return r < MP ? (r & (TP - 1)) : (r - MP); }

#define XB_TMO      128
#define XB_XCNT(j)  (256  + 64 * (j))
#define XB_XSUB(j)  (1280 + 64 * (j))
#define XB_XGEN(j)  (2304 + 64 * (j))
#define XB_TOP      3328
#define XB_TOPGEN   3392
#define XCD_BAR_WORDS 3456
#define XB_SPIN_CAP (1u << 18)
__device__ __forceinline__ unsigned xb_ld(unsigned* p)              { return __hip_atomic_load(p, __ATOMIC_RELAXED, __HIP_MEMORY_SCOPE_AGENT); }
__device__ __forceinline__ unsigned xb_add(unsigned* p, unsigned v) { return __hip_atomic_fetch_add(p, v, __ATOMIC_RELAXED, __HIP_MEMORY_SCOPE_AGENT); }
__device__ __forceinline__ unsigned xb_xcc_id() { return (unsigned)__builtin_amdgcn_s_getreg((3 << 11) | 20) & 0xFu; }
#define XB_SPIN(cond, bar) do { unsigned _sp = 0; while (cond) { __builtin_amdgcn_s_sleep(1); \
    if ((++_sp & 255u) == 0u) { if (xb_ld(&(bar)[XB_TMO])) break; if (_sp > XB_SPIN_CAP) { atomicAdd(&(bar)[XB_TMO], 1u); break; } } } } while (0)
struct XcdBarrier { unsigned* bar; unsigned x; volatile LAS unsigned* st; };
__device__ __forceinline__ XcdBarrier xcd_barrier_post(unsigned* bar, volatile LAS unsigned* st) {
    XcdBarrier b; b.bar = bar; b.x = xb_xcc_id(); b.st = st;
    if (threadIdx.x == 0) (void)xb_add(&bar[XB_XCNT(b.x)], 1u);
    return b;
}
__device__ __forceinline__ void xcd_barrier_complete(unsigned* bar, unsigned x, unsigned& nloc, unsigned& nx) {
    const unsigned G = gridDim.x * gridDim.y * gridDim.z;
    unsigned sum, cnt, mine, sp = 0u;
    for (;;) {
        sum = 0u; cnt = 0u; mine = 0u;
#pragma unroll
        for (unsigned j = 0; j < 16; ++j) { const unsigned c = xb_ld(&bar[XB_XCNT(j)]); sum += c; cnt += (c > 0u) ? 1u : 0u; mine = (j == x) ? c : mine; }
        if (sum == G) break;
        __builtin_amdgcn_s_sleep(1);
        if ((++sp & 255u) == 0u) { if (xb_ld(&bar[XB_TMO])) break; if (sp > XB_SPIN_CAP) { atomicAdd(&bar[XB_TMO], 1u); break; } }
    }
    nloc = mine > 0u ? mine : 1u; nx = cnt > 0u ? cnt : 1u;
}
__device__ __forceinline__ void xcd_barrier(const XcdBarrier& b) {
    asm volatile("s_waitcnt vmcnt(0)" ::: "memory");
    __syncthreads();
    if (threadIdx.x == 0) {
        unsigned* bar = b.bar;
        __builtin_amdgcn_s_waitcnt(0);
        unsigned nloc = b.st[0], nx = b.st[1];
        if (nloc == 0u) { xcd_barrier_complete(bar, b.x, nloc, nx); b.st[0] = nloc; b.st[1] = nx; }
        const unsigned old = xb_add(&bar[XB_XSUB(b.x)], 1u);
        const unsigned gen = old / nloc;
        if (old + 1u == (gen + 1u) * nloc) {
            __builtin_amdgcn_fence(__ATOMIC_RELEASE, "agent");
            asm volatile("s_waitcnt vmcnt(0)" ::: "memory");
            const unsigned og = xb_add(&bar[XB_TOP], 1u);
            const unsigned tg = og / nx;
            if (og + 1u == (tg + 1u) * nx) xb_add(&bar[XB_TOPGEN], 1u);
            else XB_SPIN(xb_ld(&bar[XB_TOPGEN]) == tg, bar);
            __builtin_amdgcn_fence(__ATOMIC_ACQUIRE, "agent");
            xb_add(&bar[XB_XGEN(b.x)], 1u);
            asm volatile("s_waitcnt vmcnt(0)" ::: "memory");
        } else {
            XB_SPIN(xb_ld(&bar[XB_XGEN(b.x)]) == gen, bar);
            __builtin_amdgcn_fence(__ATOMIC_ACQUIRE, "agent");
            asm volatile("s_waitcnt vmcnt(0)" ::: "memory");
        }
    }
    __syncthreads();
}

namespace pg8 {
constexpr int BM = 256, BK = 64, HALF = 128, HTB = HALF * BK * 2, STAGE_BYTES = 8 * HTB, NXCD = 8, WGM = 4;
__host__ __device__ __forceinline__ int lds_byte(int r, int c) { const int st = (r >> 4) * 2 + (c >> 5), rr = r & 15, cc = c & 31, ob = rr * 64 + cc * 2; return st * 1024 + (ob ^ (((ob >> 9) & 1) << 5)); }
__host__ __device__ __forceinline__ void stage_rc(int b, int& R, int& C) { const int st = b / 1024, sb = b % 1024, swz = sb ^ (((sb >> 9) & 1) << 5); R = (st >> 1) * 16 + swz / 64; C = (st & 1) * 32 + (swz % 64) / 2; }
struct Unit { int pm, pn; };
struct Gemm { const bf16* A; const bf16* Bt; int M, N, K; };
struct StaticOrder {
    int nM, nN, nwg, G, c;
    __host__ __device__ void init(int M_, int N_, int G_, int c_) { nM = M_ / BM; nN = N_ / BM; nwg = nM * nN; G = G_; c = c_; }
    __host__ __device__ bool next(int i, Unit& u) const {
        const long L = (long)i * G + c; if (L >= nwg) return false;
        int wgid = (int)L; { const int q = nwg / NXCD, r = nwg % NXCD, xcd = wgid % NXCD, off = wgid / NXCD; wgid = (xcd < r ? xcd * (q + 1) : r * (q + 1) + (xcd - r) * q) + off; }
        const int nig = WGM * nN, gid = wgid / nig, fm = gid * WGM, gsz = (nM - fm) < WGM ? (nM - fm) : WGM;
        u.pm = fm + ((wgid % nig) % gsz); u.pn = (wgid % nig) / gsz; return true;
    }
};
template <class Epi>
__device__ __forceinline__ void gemm_phase(LAS unsigned char* lds, const Gemm g, const StaticOrder& S, const Epi& E) {
    int tid = threadIdx.x; asm volatile("" : "+v"(tid));
    const int wid = __builtin_amdgcn_readfirstlane(tid >> 6), lane = tid & 63, wr = wid >> 2, wc = wid & 3, fr = lane & 15, fq = lane >> 4;
    const int K = g.K, nt = K / BK;
    unsigned voffA[2];
#pragma unroll
    for (int i = 0; i < 2; ++i) { int R, C; stage_rc(tid * 16 + i * 8192, R, C); voffA[i] = (unsigned)(R * K + C) * 2u; }
    const size_t kstep = (size_t)(BK * 2);
    const size_t hstep = (size_t)HALF * K * 2;
    const size_t tstep = 2 * hstep;
    const unsigned ldsw = (unsigned)wid * 1024u;
    const int aoff = lds_byte(wr * 64 + fr, fq * 8), boff = lds_byte(wc * 32 + fr, fq * 8);
#define PG8_SA(b, h) (((b) * 2 + (h)) * HTB)
#define PG8_SB(b, h) ((4 + (b) * 2 + (h)) * HTB)
#define PG8_STAGE(bufoff, gbase) do { _Pragma("unroll") for (int _i = 0; _i < 2; ++_i) \
        __builtin_amdgcn_global_load_lds((const unsigned*)((const char*)(gbase) + voffA[_i]), (LAS unsigned*)(lds + (bufoff) + ldsw + _i * 8192), 16, 0, 0); } while (0)
#define PG8_LDA(dst, b, h) do { _Pragma("unroll") for (int m = 0; m < 4; ++m) _Pragma("unroll") for (int k = 0; k < 2; ++k) dst[m][k] = *(const LAS bf16x8*)(lds + PG8_SA(b, h) + aoff + m * 2048 + k * 1024); } while (0)
#define PG8_LDB(dst, b, h) do { _Pragma("unroll") for (int n = 0; n < 2; ++n) _Pragma("unroll") for (int k = 0; k < 2; ++k) dst[n][k] = *(const LAS bf16x8*)(lds + PG8_SB(b, h) + boff + n * 2048 + k * 1024); } while (0)
#define PG8_MMA(ai, bj, At, Bt) do { __builtin_amdgcn_s_setprio(1); _Pragma("unroll") for (int m = 0; m < 4; ++m) _Pragma("unroll") for (int n = 0; n < 2; ++n) _Pragma("unroll") for (int k = 0; k < 2; ++k) \
        acc[ai][bj][m][n] = __builtin_amdgcn_mfma_f32_16x16x32_bf16(Bt[n][k], At[m][k], acc[ai][bj][m][n], 0, 0, 0); __builtin_amdgcn_s_setprio(0); } while (0)
#define PG8_WAIT_V(n) asm volatile("s_waitcnt vmcnt(" #n ")" ::: "memory")
#define PG8_WAIT_L(n) asm volatile("s_waitcnt lgkmcnt(" #n ")" ::: "memory")
#define PG8_BAR __builtin_amdgcn_s_barrier()
#define PG8_SCHED __builtin_amdgcn_sched_barrier(0)
    Unit cur, nxt; int ui = 0;
    if (!S.next(0, cur)) return;
    f32x4 acc[2][2][4][2];
#pragma unroll
    for (int a = 0; a < 2; ++a)
#pragma unroll
        for (int b = 0; b < 2; ++b)
#pragma unroll
            for (int m = 0; m < 4; ++m)
#pragma unroll
                for (int n = 0; n < 2; ++n) acc[a][b][m][n] = (f32x4){0.f, 0.f, 0.f, 0.f};
    bf16x8 At[4][2], B0[2][2], B1[2][2];
    const char* cA = (const char*)g.A + (size_t)cur.pm * tstep; const char* cB = (const char*)g.Bt + (size_t)cur.pn * tstep;
    PG8_STAGE(PG8_SB(0, 0), cB); PG8_STAGE(PG8_SB(0, 1), cB + hstep); PG8_STAGE(PG8_SA(0, 0), cA); PG8_STAGE(PG8_SA(0, 1), cA + hstep);
    if (wr == 1) PG8_BAR;
    PG8_WAIT_V(2); PG8_BAR;
    PG8_STAGE(PG8_SB(1, 0), cB + kstep); PG8_STAGE(PG8_SA(1, 0), cA + kstep); PG8_STAGE(PG8_SB(1, 1), cB + hstep + kstep);
    PG8_WAIT_V(6); PG8_BAR;
    for (;;) {
        const bool has_next = S.next(ui + 1, nxt);
        const char* nA = has_next ? (const char*)g.A + (size_t)nxt.pm * tstep : cA; const char* nB = has_next ? (const char*)g.Bt + (size_t)nxt.pn * tstep : cB;
        for (int t = 0; t < nt; t += 2) {
            const bool last = (t == nt - 2);
            const char* a1 = cA + (size_t)(t + 1) * kstep;
            const char* a2 = last ? nA : cA + (size_t)(t + 2) * kstep; const char* b2 = last ? nB : cB + (size_t)(t + 2) * kstep;
            const char* a3 = a2 + kstep; const char* b3 = b2 + kstep;
            PG8_LDB(B0, 0, 0); PG8_LDB(B1, 0, 1); PG8_SCHED; PG8_LDA(At, 0, 0); PG8_STAGE(PG8_SA(1, 1), a1 + hstep);
            PG8_WAIT_V(8); PG8_WAIT_L(0); PG8_BAR; PG8_MMA(0, 0, At, B0); PG8_MMA(0, 1, At, B1); PG8_BAR; PG8_SCHED;
            PG8_LDA(At, 0, 1); PG8_STAGE(PG8_SB(0, 0), b2); PG8_STAGE(PG8_SB(0, 1), b2 + hstep); PG8_STAGE(PG8_SA(0, 0), a2);
            PG8_WAIT_V(8); PG8_WAIT_L(0); PG8_BAR; PG8_MMA(1, 0, At, B0); PG8_MMA(1, 1, At, B1); PG8_BAR; PG8_SCHED;
            PG8_LDB(B0, 1, 0); PG8_LDB(B1, 1, 1); PG8_SCHED; PG8_LDA(At, 1, 0); PG8_STAGE(PG8_SA(0, 1), a2 + hstep);
            PG8_WAIT_V(8); PG8_WAIT_L(0); PG8_BAR; PG8_MMA(0, 0, At, B0); PG8_MMA(0, 1, At, B1); PG8_BAR; PG8_SCHED;
            PG8_LDA(At, 1, 1); PG8_STAGE(PG8_SB(1, 0), b3); PG8_STAGE(PG8_SB(1, 1), b3 + hstep); PG8_STAGE(PG8_SA(1, 0), a3);
            PG8_WAIT_V(8); PG8_WAIT_L(0); PG8_BAR; PG8_MMA(1, 0, At, B0); PG8_MMA(1, 1, At, B1); PG8_BAR; PG8_SCHED;
        }
        if (wr == 0) PG8_BAR;
        E(acc, cur, wr, wc, fr, fq);
        if (!has_next) break;
#pragma unroll
        for (int a = 0; a < 2; ++a)
#pragma unroll
            for (int b = 0; b < 2; ++b)
#pragma unroll
                for (int m = 0; m < 4; ++m)
#pragma unroll
                    for (int n = 0; n < 2; ++n) acc[a][b][m][n] = (f32x4){0.f, 0.f, 0.f, 0.f};
        cur = nxt; cA = nA; cB = nB; ++ui;
        if (wr == 1) PG8_BAR;
    }
    PG8_WAIT_V(0);
    PG8_BAR;
#undef PG8_SA
#undef PG8_SB
#undef PG8_STAGE
#undef PG8_LDA
#undef PG8_LDB
#undef PG8_MMA
#undef PG8_WAIT_V
#undef PG8_WAIT_L
#undef PG8_BAR
#undef PG8_SCHED
}

struct EpiQKV {
    bf16* O; const float* gains  ; const float2* rope  ;
    __device__ __forceinline__ void operator()(f32x4 (&acc)[2][2][4][2], const Unit& u, int wr, int wc, int fr, int fq) const {
        const int hg = u.pn * 4 + wc;
        int gi = -1; bool isq = false, rp = false;
        if (hg < 8) { gi = 0; isq = true; } else if (hg < 10) gi = 1; else if (hg < 12) gi = -1;
        else if (hg < 20) { gi = 2; isq = true; } else if (hg < 28) gi = 3; else if (hg < 36) gi = -1;
        else if (hg < 44) { gi = 4; isq = true; } else if (hg < 52) gi = 5; else if (hg < 60) gi = -1;
        else if (hg < 68) { gi = 6; isq = true; rp = true; } else if (hg < 70) { gi = 7; rp = true; }
        f32x4 gv[2][2];
#pragma unroll
        for (int bj = 0; bj < 2; ++bj)
#pragma unroll
            for (int n = 0; n < 2; ++n) { gv[bj][n] = (gi >= 0) ? *(const f32x4*)(gains + gi * 64 + 32 * (fq & 1) + 16 * n + 8 * (fq >> 1) + 4 * bj) : (f32x4){1.f, 1.f, 1.f, 1.f}; if (isq) gv[bj][n] = gv[bj][n] * QSCALE; }
#pragma unroll
        for (int ai = 0; ai < 2; ++ai)
#pragma unroll
            for (int m = 0; m < 4; ++m) {
                const int row = u.pm * BM + ai * HALF + wr * 64 + m * 16 + fr;
                f32x4 v[2][2];
#pragma unroll
                for (int bj = 0; bj < 2; ++bj)
#pragma unroll
                    for (int n = 0; n < 2; ++n) v[bj][n] = acc[ai][bj][m][n];
                float rstd = 1.f;
                if (gi >= 0) {
                    float ss = 0.f;
#pragma unroll
                    for (int bj = 0; bj < 2; ++bj)
#pragma unroll
                        for (int n = 0; n < 2; ++n) ss += (v[bj][n][0] * v[bj][n][0] + v[bj][n][1] * v[bj][n][1]) + (v[bj][n][2] * v[bj][n][2] + v[bj][n][3] * v[bj][n][3]);
                    ss += __shfl_xor(ss, 16); ss += __shfl_xor(ss, 32);
                    rstd = __builtin_amdgcn_rsqf(ss * (1.0f / 64.0f) + 1e-6f);
                }
#pragma unroll
                for (int bj = 0; bj < 2; ++bj)
#pragma unroll
                    for (int n = 0; n < 2; ++n) v[bj][n] = v[bj][n] * (gv[bj][n] * rstd);
                if (rp) {
                    const int t = pos_of_row(row);
                    const int pos = (fq & 1) ? (t & 63) : (t >> 6);
#pragma unroll
                    for (int bj = 0; bj < 2; ++bj) {
                        const float2* rp_ = rope + pos * 16 + 8 * (fq >> 1) + 4 * bj;
                        const f32x4 cs0 = *(const f32x4*)rp_, cs1 = *(const f32x4*)(rp_ + 2);
                        const float c[4] = {cs0[0], cs0[2], cs1[0], cs1[2]}, s[4] = {cs0[1], cs0[3], cs1[1], cs1[3]};
#pragma unroll
                        for (int i = 0; i < 4; ++i) { const float x1 = v[bj][0][i], x2 = v[bj][1][i]; v[bj][0][i] = x1 * c[i] - x2 * s[i]; v[bj][1][i] = x2 * c[i] + x1 * s[i]; }
                    }
                }
                bf16* rowp = O + (size_t)row * INW + hg * 64 + 32 * (fq & 1) + 8 * (fq >> 1);
#pragma unroll
                for (int n = 0; n < 2; ++n) { u32x4 w; w.x = cvtpk(v[0][n][0], v[0][n][1]); w.y = cvtpk(v[0][n][2], v[0][n][3]); w.z = cvtpk(v[1][n][0], v[1][n][1]); w.w = cvtpk(v[1][n][2], v[1][n][3]);
                    *(u32x4*)(rowp + 16 * n) = w; }
            }
    }
};
struct EpiResid {
    void* dst; const void* srcp; const void* srcs;
    const float* gate  ; float gsc; int src_f32, dst_f32, pad_;
    __device__ __forceinline__ void operator()(f32x4 (&acc)[2][2][4][2], const Unit& u, int wr, int wc, int fr, int fq) const {
        const int b = seq_of_row(u.pm * BM);
        const int col0 = u.pn * BM + wc * 32 + fq * 8;
        const float* gvec = gate + (size_t)b * (6 * DM) + col0;
        f32x4 gv[2][2];
#pragma unroll
        for (int bj = 0; bj < 2; ++bj)
#pragma unroll
            for (int n = 0; n < 2; ++n) gv[bj][n] = *(const f32x4*)(gvec + bj * HALF + n * 4) * gsc;
#pragma unroll
        for (int am = 0; am < 4; ++am) {
            const int ai = am >> 1;
            f32x4 xv[2][2][2];
#pragma unroll
            for (int mm = 0; mm < 2; ++mm) { const int m = (am & 1) * 2 + mm; const int row = u.pm * BM + ai * HALF + wr * 64 + m * 16 + fr;
                const size_t eo = ((row < MP) ? (size_t)row : (size_t)(row - MP)) * DM + col0;
                if (src_f32) { const float* rp = (const float*)((row < MP) ? srcp : srcs) + eo;
#pragma unroll
                    for (int bj = 0; bj < 2; ++bj)
#pragma unroll
                        for (int n = 0; n < 2; ++n) xv[mm][bj][n] = *(const f32x4*)(rp + bj * HALF + n * 4); }
                else { const bf16* rp = (const bf16*)((row < MP) ? srcp : srcs) + eo;
#pragma unroll
                    for (int bj = 0; bj < 2; ++bj) { const u32x4 w = *(const u32x4*)(rp + bj * HALF);
                        xv[mm][bj][0] = (f32x4){__uint_as_float(w.x << 16), __uint_as_float(w.x & 0xffff0000u), __uint_as_float(w.y << 16), __uint_as_float(w.y & 0xffff0000u)};
                        xv[mm][bj][1] = (f32x4){__uint_as_float(w.z << 16), __uint_as_float(w.z & 0xffff0000u), __uint_as_float(w.w << 16), __uint_as_float(w.w & 0xffff0000u)}; } }
            }
#pragma unroll
            for (int mm = 0; mm < 2; ++mm) { const int m = (am & 1) * 2 + mm; const size_t eo = (size_t)(u.pm * BM + ai * HALF + wr * 64 + m * 16 + fr) * DM + col0;
#pragma unroll
                for (int bj = 0; bj < 2; ++bj) { const f32x4 x0 = xv[mm][bj][0] + gv[bj][0] * acc[ai][bj][m][0], x1 = xv[mm][bj][1] + gv[bj][1] * acc[ai][bj][m][1];
                    if (dst_f32) { *(f32x4*)((float*)dst + eo + bj * HALF) = x0; *(f32x4*)((float*)dst + eo + bj * HALF + 4) = x1; }
                    else { u32x4 w; w.x = cvtpk(x0[0], x0[1]); w.y = cvtpk(x0[2], x0[3]); w.z = cvtpk(x1[0], x1[1]); w.w = cvtpk(x1[2], x1[3]); *(u32x4*)((bf16*)dst + eo + bj * HALF) = w; } }
            }
            asm volatile("" ::: "memory");
        }
    }
};
struct EpiSwiglu {
    bf16* O;
    __device__ __forceinline__ void operator()(f32x4 (&acc)[2][2][4][2], const Unit& u, int wr, int wc, int fr, int fq) const {
#pragma unroll
        for (int ai = 0; ai < 2; ++ai)
#pragma unroll
            for (int m = 0; m < 4; ++m) {
                const int row = u.pm * BM + ai * HALF + wr * 64 + m * 16 + fr;
                float a[2][4];
#pragma unroll
                for (int bj = 0; bj < 2; ++bj)
#pragma unroll
                    for (int i = 0; i < 4; ++i) { const float gg = acc[ai][bj][m][0][i], uu = acc[ai][bj][m][1][i]; a[bj][i] = gg * uu * __builtin_amdgcn_rcpf(1.0f + __builtin_amdgcn_exp2f(-gg * LOG2E)); }
                u32x4 w; w.x = cvtpk(a[0][0], a[0][1]); w.y = cvtpk(a[0][2], a[0][3]); w.z = cvtpk(a[1][0], a[1][1]); w.w = cvtpk(a[1][2], a[1][3]);
                *(u32x4*)(O + (size_t)row * FF + u.pn * 128 + wc * 32 + fq * 8) = w;
            }
    }
};
}

namespace att {
constexpr int A_K = 0, A_V = 24576, A_WSF = 73728, A_LUT = 75776, A_END = 92416;
constexpr int LUTW = 1025, LUTC = 512;
struct AU {
    const bf16* q; const bf16* k; const bf16* v; long rs;
    int q0, kv0, nt;
    int W, hcol, rmul;
    void* o; long ors;
    float* lse; long lrs;
    int sink4, has_sink;
    float mfix; int res;
    int wsh, of32;
};
__device__ __forceinline__ int crow(int r, int hi) { return (r & 3) + 8 * (r >> 2) + 4 * hi; }
__device__ __forceinline__ void glds16(const void* gsrc, unsigned lds_dst) { unsigned keep;
    asm volatile("s_mov_b32 %0, m0\n\ts_mov_b32 m0, %2\n\ts_nop 0\n\tglobal_load_lds_dwordx4 %1, off\n\ts_mov_b32 m0, %0" : "=&s"(keep) : "v"(gsrc), "s"(lds_dst) : "memory"); }
#define LDS_ADDR(p) ((unsigned)__builtin_amdgcn_readfirstlane((int)(unsigned)(size_t)(p)))
__device__ __forceinline__ int t5_bucket(int rel) {
    const int n = rel < 0 ? -rel : rel;
    const int v = n < 8 ? n : 8 + (n >= 15) + (n >= 27) + (n >= 50) + (n >= 91) + (n >= 166) + (n >= 305) + (n >= 559);
    return v + (rel > 0 ? 16 : 0);
}
template <int MODE>
__device__ __forceinline__ void attn_dense(const AU& u, LAS unsigned char* lds, const float* __restrict__ relpos) {
    constexpr int DV = (MODE == 1) ? 128 : 64, NDB = DV / 32, VSLOT = 64 * DV * 2, NVP = DV / 64;
    constexpr int CL = 656;
    constexpr int A_Vx = (MODE == 2) ? 49152 : A_V, A_WSFx = (MODE == 2) ? 98304 : A_WSF, A_LUTx = (MODE == 2) ? 100352 : A_LUT;
    constexpr float THR = 8.0f;
    int tid = threadIdx.x; asm volatile("" : "+v"(tid));
    const int lane = tid & 63, r32 = lane & 31, hi = lane >> 5; const int wid = __builtin_amdgcn_readfirstlane(tid >> 6);
    const bf16* ksrc = u.k + (long)(u.kv0 + lane) * u.rs + wid * 8;
    const bf16* vsrc = u.v + (long)(u.kv0 + 16 * (wid & 3) + (lane >> 2)) * u.rs + (wid >> 2) * 32 + (lane & 3) * 8;
    const long tstride = 64 * u.rs;
#define DN_DMA_K(t, slot) glds16(ksrc + (long)(t) * tstride, LDS_ADDR(lds + A_K + (slot) * 8192 + wid * 1024))
#define DN_DMA_V(t, slot) do { \
      glds16(vsrc + (long)(t) * tstride, LDS_ADDR(lds + A_Vx + (slot) * VSLOT + wid * 1024)); \
      if (DV == 128) glds16(vsrc + (long)(t) * tstride + 64, LDS_ADDR(lds + A_Vx + (slot) * VSLOT + (wid + 8) * 1024)); \
    } while (0)
    const bool res = (MODE == 2) && (u.res != 0);
    if (res) { for (int j = 0; j < u.nt; ++j) { DN_DMA_K(j, j); DN_DMA_V(j, j); } }
    else { DN_DMA_K(0, 0); DN_DMA_V(0, 0); DN_DMA_K(1, 1); DN_DMA_K(2, 2); }
    LAS float* lut = (LAS float*)(lds + A_LUTx);
    LAS float* wsf = (LAS float*)(lds + A_WSFx) + wid * 64;
    const int gh = (MODE == 2) ? (wid >> u.wsh) : 0;
    const int qw = (MODE == 2) ? (u.q0 + 32 * (wid & ((1 << u.wsh) - 1))) : (u.q0 + wid * 32);
    bf16x8 qr[4];
    { const bf16* qp = u.q + (long)(qw + r32) * u.rs + hi * 8 + 64 * gh;
#pragma unroll
      for (int d0 = 0; d0 < 4; ++d0) qr[d0] = *(const bf16x8*)(qp + d0 * 16); }
    float bL = 0.f, bR = 0.f;
    if (MODE == 1) {
        float tv[3];
#pragma unroll
        for (int k = 0; k < 3; ++k) { const int i = tid + 512 * k; tv[k] = (i < 2 * CL + 1) ? relpos[t5_bucket(i - CL) * 20 + u.hcol] : 0.f; }
        bL = relpos[15 * 20 + u.hcol] * LOG2E; bR = relpos[31 * 20 + u.hcol] * LOG2E;
#pragma unroll
        for (int k = 0; k < 3; ++k) { const int i = tid + 512 * k; if (i < 2 * CL + 1) lut[i] = tv[k] * LOG2E; }
    }
    if (MODE == 2) {
        const int ng = 8 >> u.wsh;
        const int nv = 2 * u.W + 1;
        float tv[3]; int ti[3];
#pragma unroll
        for (int k = 0; k < 3; ++k) { const int j = tid + 512 * k; const int gg = j / nv, rel = (j % nv) - u.W; ti[k] = (j < ng * nv) ? gg * LUTW + rel + LUTC : -1;
            tv[k] = (j < ng * nv) ? relpos[t5_bucket(rel * u.rmul) * 20 + u.hcol + gg] : 0.f; }
        for (int i = tid; i < ng * LUTW; i += 512) { const int rel = (i % LUTW) - LUTC; const int ar = rel < 0 ? -rel : rel; if (ar > u.W) lut[i] = NEG_BIG; }
#pragma unroll
        for (int k = 0; k < 3; ++k) if (ti[k] >= 0) lut[ti[k]] = tv[k] * LOG2E;
        lut += gh * LUTW;
    }
    const int tlo_ = (qw - u.W - u.kv0) > 0 ? ((qw - u.W - u.kv0) >> 6) : 0;
    const int ta = res ? (tlo_ < u.nt - u.res ? tlo_ : u.nt - u.res) : 0;
    const int nt = res ? u.res : u.nt;
    const int ntd = res ? 0 : u.nt;
    const int kv0w = u.kv0 + 64 * ta;
#define SBAR() __builtin_amdgcn_sched_barrier(0)
#define PIN(x) asm volatile("" : "+v"(x))
#define EX2(v) __builtin_amdgcn_exp2f(v)
#define MFMA32(a, b, c) __builtin_amdgcn_mfma_f32_32x32x16_bf16(a, b, c, 0, 0, 0)
#define DN_KLOAD2(Ks_, j) do { kf[2 * (j)] = *(const LAS bf16x8*)((Ks_) + (j) * 2048); kf[2 * (j) + 1] = *(const LAS bf16x8*)((Ks_) + (j) * 2048 + 512); } while (0)
#define DN_VFRAG(dst, Vs_, db, ks) do { \
      const s16x4 lo_ = __builtin_bit_cast(s16x4, __builtin_amdgcn_ds_read_tr16_b64_v4i16((LAS s16x4*)((Vs_) + ((db) * 4 + (ks)) * 1024))); \
      const s16x4 hh_ = __builtin_bit_cast(s16x4, __builtin_amdgcn_ds_read_tr16_b64_v4i16((LAS s16x4*)((Vs_) + ((db) * 4 + (ks)) * 1024 + 512))); \
      dst = (bf16x8){lo_[0], lo_[1], lo_[2], lo_[3], hh_[0], hh_[1], hh_[2], hh_[3]}; } while (0)
#define DN_KIND(t_) ((MODE == 1) ? ((kv0w + 64 * (t_) + 63 - qw <= -559) ? 2 : (kv0w + 64 * (t_) - qw - 31 >= 559) ? 3 : 1) : (MODE == 2) ? 1 : 0)
#define DN_BIAS(S0, S1, t_) do { const LAS float* lp_ = lut + (kv0w + 64 * (t_) - (qw + r32) + 4 * hi + ((MODE == 2) ? LUTC : CL)); \
      _Pragma("unroll") for (int r = 0; r < 16; ++r) { S0[r] += lp_[(r & 3) + 8 * (r >> 2)]; S1[r] += lp_[32 + (r & 3) + 8 * (r >> 2)]; } } while (0)
#define MX3(a, b, c) __builtin_fmaxf(__builtin_fmaxf((a), (b)), (c))
#define DN_ROWMAX(rm_, S0, S1) do { float ra_ = MX3(S0[0], S0[1], S1[0]), rb_ = MX3(S0[2], S0[3], S1[1]); ra_ = MX3(ra_, S1[2], S1[3]); \
      _Pragma("unroll") for (int r = 4; r < 16; r += 4) { ra_ = MX3(ra_, S0[r], S0[r + 1]); rb_ = MX3(rb_, S0[r + 2], S0[r + 3]); ra_ = MX3(ra_, S1[r], S1[r + 1]); rb_ = MX3(rb_, S1[r + 2], S1[r + 3]); } \
      rm_ = __builtin_fmaxf(ra_, rb_); rm_ = __builtin_fmaxf(rm_, __shfl_xor(rm_, 32)); } while (0)
#define PKW(P, B) cvtpk(P[B], P[(B) + 1])
    const int koff = hi * 1024 + r32 * 16;
    const int voff = ((lane >> 4) & 1) * 32 + (lane & 3) * 8 + (4 * hi + ((lane & 15) >> 2)) * 64;
    const float mfix = u.mfix;
    float l_run = 0.f, cb_cur = 0.f;
    f32x16 o[NDB];
#pragma unroll
    for (int db = 0; db < NDB; ++db)
#pragma unroll
        for (int r = 0; r < 16; ++r) o[db][r] = 0.f;
    f32x16 negm;
    const f32x16 zero16 = {0.f, 0.f, 0.f, 0.f, 0.f, 0.f, 0.f, 0.f, 0.f, 0.f, 0.f, 0.f, 0.f, 0.f, 0.f, 0.f};
#define CINIT ((MODE != 1) ? negm : zero16)
#pragma unroll
    for (int r = 0; r < 16; ++r) negm[r] = -mfix;
    asm volatile("" : "+v"(negm));
    bf16x8 kf[8];
    u32x4 pw0, pw1, pw2, pw3;
    f32x16 pA0, pA1, pB0, pB1;
    asm volatile("s_waitcnt vmcnt(0) lgkmcnt(0)" ::: "memory");
    __builtin_amdgcn_s_barrier();
    asm volatile("" ::: "memory");
#define DN_SETCB(t_) do { const int kind_ = DN_KIND(t_); const float cbn_ = (kind_ == 2) ? bL : (kind_ == 3) ? bR : 0.f; \
        if (MODE == 1) cb_cur = cbn_; } while (0)
    {
        const LAS unsigned char* Ks = lds + A_K + ta * 8192 + koff;
        DN_KLOAD2(Ks, 0); DN_KLOAD2(Ks, 1); DN_KLOAD2(Ks, 2); DN_KLOAD2(Ks, 3);
        DN_SETCB(0);
        pA0 = MFMA32(kf[0], qr[0], CINIT); pA1 = MFMA32(kf[1], qr[0], CINIT);
#pragma unroll
        for (int d0 = 1; d0 < 4; ++d0) { pA0 = MFMA32(kf[2 * d0], qr[d0], pA0); pA1 = MFMA32(kf[2 * d0 + 1], qr[d0], pA1); }
        if (MODE != 0 && DN_KIND(0) == 1) DN_BIAS(pA0, pA1, 0);
        { const float shf = (MODE == 1) ? (cb_cur - mfix) : 0.f;
#pragma unroll
          for (int r = 0; r < 16; ++r) { pA0[r] = EX2(pA0[r] + shf); pA1[r] = EX2(pA1[r] + shf); } }
        asm volatile("s_waitcnt lgkmcnt(0)" ::: "memory");
        if (!res) __builtin_amdgcn_s_barrier();
        asm volatile("" ::: "memory");
        if (!res) { DN_DMA_K(3, 0); DN_DMA_V(1, 1); }
        const LAS unsigned char* Ks1 = lds + A_K + (ta + 1) * 8192 + koff;
        DN_KLOAD2(Ks1, 0); DN_KLOAD2(Ks1, 1); DN_KLOAD2(Ks1, 2); DN_KLOAD2(Ks1, 3);
        if (NVP == 1) asm volatile("s_waitcnt vmcnt(2) lgkmcnt(0)" ::: "memory"); else asm volatile("s_waitcnt vmcnt(3) lgkmcnt(0)" ::: "memory");
        if (!res) __builtin_amdgcn_s_barrier();
        asm volatile("" ::: "memory");
    }
    int sl_prev = ta, sl_cur = ta + 1, sl_next = ta + 2;
    if (wid >= 4) __builtin_amdgcn_s_setprio(1);
#define PAF(k) __builtin_bit_cast(bf16x8, pw##k)
#define GAPA(VI, DB, KS, MF, A0, A1, A2, A3, W0, W1, PW) do { DN_VFRAG(vf[VI], Vs, DB, KS); SBAR(); MF; sacc += A0; sacc += A1; sacc += A2; sacc += A3; PIN(sacc); W0; W1; PIN(PW); SBAR(); } while (0)
#define GAPB4(MF, X, B, KJ) do { MF; X[B] = EX2(X[B]); X[(B) + 1] = EX2(X[(B) + 1]); X[(B) + 2] = EX2(X[(B) + 2]); X[(B) + 3] = EX2(X[(B) + 3]); PIN(X); if ((KJ) >= 0) DN_KLOAD2(Kn, (KJ) < 0 ? 0 : (KJ)); SBAR(); } while (0)
#define GAPB2(MF, X, B, AFTER) do { MF; X[B] = EX2(X[B] + shf); X[(B) + 1] = EX2(X[(B) + 1] + shf); PIN(X); AFTER; SBAR(); } while (0)
#define DN_STEP(P0, P1, C0, C1, t_) do { \
        const LAS unsigned char* Vs = lds + A_Vx + sl_prev * VSLOT + voff; \
        const LAS unsigned char* Kn = lds + A_K + sl_next * 8192 + koff; \
        DN_SETCB(t_); \
        bf16x8 vf[8]; \
        SBAR(); \
        float sacc = P0[0] + P0[1]; \
        GAPA(0, 0, 0, C0 = MFMA32(kf[0], qr[0], CINIT), P0[2], P0[3], P0[4], P0[5],     pw0[0] = PKW(P0, 0),  pw0[1] = PKW(P0, 2),  pw0); \
        GAPA(1, 1, 0, C1 = MFMA32(kf[1], qr[0], CINIT), P0[6], P0[7], P0[8], P0[9],     pw0[2] = PKW(P0, 4),  pw0[3] = PKW(P0, 6),  pw0); \
        GAPA(2, 0, 1, C0 = MFMA32(kf[2], qr[1], C0),   P0[10], P0[11], P0[12], P0[13], pw1[0] = PKW(P0, 8),  pw1[1] = PKW(P0, 10), pw1); \
        GAPA(3, 1, 1, C1 = MFMA32(kf[3], qr[1], C1),   P0[14], P0[15], P1[0], P1[1],   pw1[2] = PKW(P0, 12), pw1[3] = PKW(P0, 14), pw1); \
        GAPA(4, 0, 2, C0 = MFMA32(kf[4], qr[2], C0),   P1[2], P1[3], P1[4], P1[5],     pw2[0] = PKW(P1, 0),  pw2[1] = PKW(P1, 2),  pw2); \
        GAPA(5, 1, 2, C1 = MFMA32(kf[5], qr[2], C1),   P1[6], P1[7], P1[8], P1[9],     pw2[2] = PKW(P1, 4),  pw2[3] = PKW(P1, 6),  pw2); \
        GAPA(6, 0, 3, C0 = MFMA32(kf[6], qr[3], C0),   P1[10], P1[11], P1[12], P1[13], pw3[0] = PKW(P1, 8),  pw3[1] = PKW(P1, 10), pw3); \
        GAPA(7, 1, 3, C1 = MFMA32(kf[7], qr[3], C1),   P1[14], P1[15], 0.f, 0.f,       pw3[2] = PKW(P1, 12), pw3[3] = PKW(P1, 14), pw3); \
        l_run += sacc; \
        if (MODE != 0 && DN_KIND(t_) == 1) DN_BIAS(C0, C1, t_); \
        const float shf = cb_cur - mfix; (void)shf; \
        SBAR(); \
        if (DV == 64) { \
            GAPB4(o[0] = MFMA32(PAF(0), vf[0], o[0]), C0, 0, -1); \
            GAPB4(o[1] = MFMA32(PAF(0), vf[1], o[1]), C0, 4, -1); \
            GAPB4(o[0] = MFMA32(PAF(1), vf[2], o[0]), C0, 8, 0); \
            GAPB4(o[1] = MFMA32(PAF(1), vf[3], o[1]), C0, 12, 1); \
            GAPB4(o[0] = MFMA32(PAF(2), vf[4], o[0]), C1, 0, 2); \
            GAPB4(o[1] = MFMA32(PAF(2), vf[5], o[1]), C1, 4, 3); \
            GAPB4(o[0] = MFMA32(PAF(3), vf[6], o[0]), C1, 8, -1); \
            if ((t_) + 3 < ntd) DN_DMA_K((t_) + 3, sl_cur); \
            GAPB4(o[1] = MFMA32(PAF(3), vf[7], o[1]), C1, 12, -1); \
            if ((t_) + 1 < ntd) DN_DMA_V((t_) + 1, sl_next); \
        } else { \
            GAPB2(o[0] = MFMA32(PAF(0), vf[0], o[0]), C0, 0,  DN_VFRAG(vf[0], Vs, 2, 0)); \
            GAPB2(o[1] = MFMA32(PAF(0), vf[1], o[1]), C0, 2,  DN_VFRAG(vf[1], Vs, 3, 0)); \
            GAPB2(o[0] = MFMA32(PAF(1), vf[2], o[0]), C0, 4,  DN_VFRAG(vf[2], Vs, 2, 1)); \
            GAPB2(o[1] = MFMA32(PAF(1), vf[3], o[1]), C0, 6,  DN_VFRAG(vf[3], Vs, 3, 1)); \
            GAPB2(o[0] = MFMA32(PAF(2), vf[4], o[0]), C0, 8,  DN_VFRAG(vf[4], Vs, 2, 2)); \
            GAPB2(o[1] = MFMA32(PAF(2), vf[5], o[1]), C0, 10, DN_VFRAG(vf[5], Vs, 3, 2)); \
            GAPB2(o[0] = MFMA32(PAF(3), vf[6], o[0]), C0, 12, DN_VFRAG(vf[6], Vs, 2, 3)); \
            GAPB2(o[1] = MFMA32(PAF(3), vf[7], o[1]), C0, 14, DN_VFRAG(vf[7], Vs, 3, 3)); \
            GAPB2(o[NDB - 2] = MFMA32(PAF(0), vf[0], o[NDB - 2]), C1, 0,  (void)0); \
            GAPB2(o[NDB - 1] = MFMA32(PAF(0), vf[1], o[NDB - 1]), C1, 2,  (void)0); \
            GAPB2(o[NDB - 2] = MFMA32(PAF(1), vf[2], o[NDB - 2]), C1, 4,  DN_KLOAD2(Kn, 0)); \
            GAPB2(o[NDB - 1] = MFMA32(PAF(1), vf[3], o[NDB - 1]), C1, 6,  DN_KLOAD2(Kn, 1)); \
            GAPB2(o[NDB - 2] = MFMA32(PAF(2), vf[4], o[NDB - 2]), C1, 8,  DN_KLOAD2(Kn, 2)); \
            GAPB2(o[NDB - 1] = MFMA32(PAF(2), vf[5], o[NDB - 1]), C1, 10, DN_KLOAD2(Kn, 3)); \
            GAPB2(o[NDB - 2] = MFMA32(PAF(3), vf[6], o[NDB - 2]), C1, 12, (void)0); \
            if ((t_) + 3 < ntd) DN_DMA_K((t_) + 3, sl_cur); \
            GAPB2(o[NDB - 1] = MFMA32(PAF(3), vf[7], o[NDB - 1]), C1, 14, (void)0); \
            if ((t_) + 1 < ntd) DN_DMA_V((t_) + 1, sl_next); \
        } \
        { const int pend = (((t_) + 3 < ntd) ? 1 : 0) + (((t_) + 1 < ntd) ? NVP : 0); \
          if (pend >= 3) asm volatile("s_waitcnt vmcnt(3) lgkmcnt(0)" ::: "memory"); \
          else if (pend == 2) asm volatile("s_waitcnt vmcnt(2) lgkmcnt(0)" ::: "memory"); \
          else if (pend == 1) asm volatile("s_waitcnt vmcnt(1) lgkmcnt(0)" ::: "memory"); \
          else asm volatile("s_waitcnt vmcnt(0) lgkmcnt(0)" ::: "memory"); } \
        if (!res) __builtin_amdgcn_s_barrier(); \
        asm volatile("" ::: "memory"); \
        { const int tmp = sl_prev; sl_prev = sl_cur; sl_cur = sl_next; sl_next = res ? sl_next + 1 : tmp; } \
    } while (0)
    int t = 1;
    for (; t + 1 < nt; t += 2) { DN_STEP(pA0, pA1, pB0, pB1, t); DN_STEP(pB0, pB1, pA0, pA1, t + 1); }
#define DN_DRAIN(X0, X1) do { \
        const LAS unsigned char* Vs = lds + A_Vx + sl_prev * VSLOT + voff; \
        float sacc = 0.f; \
        _Pragma("unroll") for (int r = 0; r < 16; ++r) sacc += X0[r] + X1[r]; \
        l_run += sacc; \
        pw0 = (u32x4){PKW(X0, 0), PKW(X0, 2), PKW(X0, 4), PKW(X0, 6)}; pw1 = (u32x4){PKW(X0, 8), PKW(X0, 10), PKW(X0, 12), PKW(X0, 14)}; \
        pw2 = (u32x4){PKW(X1, 0), PKW(X1, 2), PKW(X1, 4), PKW(X1, 6)}; pw3 = (u32x4){PKW(X1, 8), PKW(X1, 10), PKW(X1, 12), PKW(X1, 14)}; \
        _Pragma("unroll") for (int dh = 0; dh < NDB / 2; ++dh) { \
            bf16x8 vf[8]; \
            _Pragma("unroll") for (int i = 0; i < 8; ++i) DN_VFRAG(vf[i], Vs, 2 * dh + (i & 1), i >> 1); \
            o[2 * dh] = MFMA32(PAF(0), vf[0], o[2 * dh]); o[2 * dh + 1] = MFMA32(PAF(0), vf[1], o[2 * dh + 1]); \
            o[2 * dh] = MFMA32(PAF(1), vf[2], o[2 * dh]); o[2 * dh + 1] = MFMA32(PAF(1), vf[3], o[2 * dh + 1]); \
            o[2 * dh] = MFMA32(PAF(2), vf[4], o[2 * dh]); o[2 * dh + 1] = MFMA32(PAF(2), vf[5], o[2 * dh + 1]); \
            o[2 * dh] = MFMA32(PAF(3), vf[6], o[2 * dh]); o[2 * dh + 1] = MFMA32(PAF(3), vf[7], o[2 * dh + 1]); \
        } } while (0)
    if (MODE == 2 && res && (nt & 1)) {
        __builtin_amdgcn_s_setprio(0);
        DN_DRAIN(pA0, pA1);
    } else {
        DN_STEP(pA0, pA1, pB0, pB1, t);
        __builtin_amdgcn_s_setprio(0);
        DN_DRAIN(pB0, pB1);
    }
#undef DN_DRAIN
#undef DN_STEP
#undef GAPA
#undef GAPB4
#undef GAPB2
#undef PAF
#undef DN_SETCB
#undef CINIT
#undef SBAR
#undef PIN
#undef EX2
#undef MFMA32
#undef DN_DMA_K
#undef DN_DMA_V
#undef DN_KLOAD2
#undef DN_VFRAG
#undef DN_KIND
#undef DN_BIAS
#undef MX3
#undef DN_ROWMAX
#undef PKW
    float lt = l_run + __shfl_xor(l_run, 32);
    if (MODE == 2 && u.has_sink) lt += __builtin_amdgcn_exp2f(((const LAS float*)(lds + MISC_OFF))[100 + u.sink4 + gh] - mfix);
    const float inv = 1.0f / lt;
    if (MODE == 2 && u.lse && hi == 0) u.lse[(long)(qw + r32) * u.lrs] = mfix + __builtin_amdgcn_logf(lt);
    if (hi == 0) wsf[32 + r32] = inv;
    asm volatile("s_waitcnt lgkmcnt(0)" ::: "memory");
#pragma unroll
    for (int r = 0; r < 16; ++r) {
        const int qi = crow(r, hi); const float f = wsf[32 + qi];
        { bf16* op = (bf16*)u.o + (long)(qw + qi) * u.ors + r32 + 64 * gh;
#pragma unroll
            for (int db = 0; db < NDB; ++db) op[db * 32] = (bf16)(cvtpk(o[db][r] * f, 0.f) & 0xffffu); }
    }
    asm volatile("s_waitcnt vmcnt(0) lgkmcnt(0)" ::: "memory");
    __builtin_amdgcn_s_barrier();
    asm volatile("" ::: "memory");
}
}

__device__ __forceinline__ float bias_max(const float* __restrict__ relpos, int col) {
    int ln = threadIdx.x & 31; asm volatile("" : "+v"(ln)); float bm = relpos[ln * 20 + col] * LOG2E;
#pragma unroll
    for (int o = 1; o < 32; o <<= 1) bm = fmaxf(bm, __shfl_xor(bm, o));
    return bm;
}
__device__ __forceinline__ float qk_bound(const float* __restrict__ g) {
    int ln = threadIdx.x & 63; asm volatile("" : "+v"(ln)); float vq = fabsf(g[ln]), vk = fabsf(g[64 + ln]);
#pragma unroll
    for (int o = 1; o < 64; o <<= 1) { vq = fmaxf(vq, __shfl_xor(vq, o)); vk = fmaxf(vk, __shfl_xor(vk, o)); }
    return 64.0f * vq * vk * QSCALE * 1.001f;
}
struct Args { const float* in[17]; float* out; unsigned char* ws; int ph_lo, ph_hi; };
enum { I_XP = 0, I_XS, I_CP, I_CS, I_WMOD, I_BMOD, I_NMIX, I_NFFN, I_WIN, I_WOUT, I_QKG, I_SINK, I_RELPOS, I_DLAM, I_DSUB, I_WGU, I_WDN };

template <int TYPE> __device__ __forceinline__ int srccol(int g0, int j) {
    if (TYPE == 0) return g0 + j;
    if (TYPE == 1) { const int n = j >> 4, fq = (j >> 2) & 3, i = j & 3; return (g0 & ~255) + 64 * ((g0 >> 5) & 3) + 32 * (fq & 1) + 16 * n + 8 * (fq >> 1) + 4 * ((g0 >> 7) & 1) + i; }
    if (TYPE == 3) return g0 + 8 * ((j >> 2) & 3) + 4 * (j >> 4) + (j & 3);
    const int pn = g0 >> 8, bj = (g0 >> 7) & 1, wc = (g0 >> 5) & 3, n = j >> 4, fq = (j >> 2) & 3, i = j & 3;
    return n * FF + 128 * pn + 32 * wc + 8 * fq + 4 * bj + i;
}
template <int TYPE> __device__ __forceinline__ void convert_item(const float* __restrict__ W, int N, int K, bf16* WT, int kb, int nb, LAS float* scr, int lane) {
    const int k0 = 64 * kb, g0 = 32 * nb;
    const int sc = srccol<TYPE>(g0, lane & 31);
#pragma unroll 8
    for (int i = 0; i < 32; ++i) { const int kk = 2 * i + (lane >> 5); scr[kk * 33 + (lane & 31)] = __builtin_nontemporal_load(W + (size_t)(k0 + kk) * N + sc); }
    asm volatile("s_waitcnt lgkmcnt(0)" ::: "memory");
    const int c = lane & 7;
#pragma unroll
    for (int j = 0; j < 4; ++j) { const int n = (lane >> 3) + 8 * j; const LAS float* s = scr + (8 * c) * 33 + n;
        u32x4 o; o.x = cvtpk(s[0 * 33], s[1 * 33]); o.y = cvtpk(s[2 * 33], s[3 * 33]); o.z = cvtpk(s[4 * 33], s[5 * 33]); o.w = cvtpk(s[6 * 33], s[7 * 33]);
        *(u32x4*)(WT + (size_t)(g0 + n) * K + k0 + 8 * c) = o; }
    asm volatile("s_waitcnt lgkmcnt(0)" ::: "memory");
}
__device__ __forceinline__ void sincos_pi4(double r, double& s, double& c) {
    const double r2 = r * r;
    s = r * (1.0 + r2 * (-1.0 / 6 + r2 * (1.0 / 120 + r2 * (-1.0 / 5040 + r2 * (1.0 / 362880 + r2 * (-1.0 / 39916800 + r2 * (1.0 / 6227020800.0)))))));
    c = 1.0 + r2 * (-0.5 + r2 * (1.0 / 24 + r2 * (-1.0 / 720 + r2 * (1.0 / 40320 + r2 * (-1.0 / 3628800 + r2 * (1.0 / 479001600 + r2 * (-1.0 / 87178291200.0)))))));
}

__global__ void __launch_bounds__(512, 2) mega_fwd(Args a) {
    extern __shared__ __attribute__((aligned(16))) unsigned char lds_raw[];
    LAS unsigned char* lds = (LAS unsigned char*)lds_raw;
    const int tid = threadIdx.x, lane = tid & 63, wave = __builtin_amdgcn_readfirstlane(tid >> 6);
    const int G = gridDim.x, bx = blockIdx.x, vcu = (G % 8 == 0) ? (bx % 8) * (G / 8) + bx / 8 : bx;
    const int gw = vcu * 8 + wave, NGW = G * 8;
    unsigned char* ws = a.ws;
    volatile LAS unsigned* MISC = (volatile LAS unsigned*)(lds + MISC_OFF);
    for (int i = tid; i < (LDS_BYTES - MISC_OFF) / 4; i += 512) ((LAS unsigned*)(lds + MISC_OFF))[i] = 0u;
    __syncthreads();
    { LAS float* tb = (LAS float*)(lds + MISC_OFF); LAS float* st = (LAS float*)lds;
      for (int i = tid; i < 640; i += 512) st[i] = a.in[I_RELPOS][i] * LOG2E;
      for (int j = wave; j < 4 * DEPTH; j += 8) { const float qb_ = qk_bound(a.in[I_QKG] + (j >> 2) * 512 + (j & 3) * 128); if (lane == 0) tb[64 + j] = qb_; }
      if (tid < 8 * DEPTH) tb[100 + tid] = a.in[I_SINK][tid] * LOG2E;
      __syncthreads();
      if (tid < 20) { float m_ = st[tid]; for (int b_ = 1; b_ < 32; ++b_) m_ = fmaxf(m_, st[b_ * 20 + tid]); tb[80 + tid] = m_; }
      __syncthreads(); }
    XcdBarrier bar = xcd_barrier_post((unsigned*)(ws + WS_CTL) + CW_BAR, MISC + 8);
    const int lo = a.ph_lo, hi_ = a.ph_hi;
#define IN(k) (lo <= (k) && (k) < hi_)
#define SEAM(k) do { if (IN(k) && IN((k) + 1)) xcd_barrier(bar); } while (0)

    float* mod = (float*)(ws + WS_MOD);
    float2* rope = (float2*)(ws + WS_ROPE);
    bf16* Win_t = (bf16*)(ws + WS_WIN); bf16* Wout_t = (bf16*)(ws + WS_WOUT); bf16* Wgu_t = (bf16*)(ws + WS_WGU); bf16* Wdn_t = (bf16*)(ws + WS_WDN);
    bf16* Hb = (bf16*)(ws + WS_H); bf16* QKV = (bf16*)(ws + WS_QKV); bf16* MIX = (bf16*)(ws + WS_MIX); bf16* ACT = (bf16*)(ws + WS_ACT);
    bf16* BSC = (bf16*)(ws + WS_BSC); float* BLSE = (float*)(ws + WS_BLSE); bf16* CSC = (bf16*)(ws + WS_CSC);
    float* X = a.out; bf16* XB = (bf16*)(ws + WS_XB);

    if (IN(0) && !SKIP_PRO) for (int rep = 0; rep < REP_PRO; ++rep) {
        int tid = threadIdx.x; asm volatile("" : "+v"(tid)); const int lane = tid & 63;
        const int gt = vcu * 512 + tid, NTH = G * 512;
        if (gt < 2048) {
            const float invf[16] = {1.f, 0.562341332f, 0.316227764f, 0.177827939f, 0.100000001f, 0.0562341325f, 0.0316227749f, 0.0177827943f, 0.00999999978f, 0.00562341325f, 0.00316227763f, 0.00177827943f, 0.00100000005f, 0.000562341302f, 0.000316227757f, 0.00017782794f};
            const int pos = gt >> 4, p = gt & 15;
            float fr = 1.f;
#pragma unroll
            for (int i = 0; i < 16; ++i) if (p == i) fr = invf[i];
            const float ang = (float)pos * fr;
            const double x = (double)ang; const double kq = __builtin_rint(x * 0.63661977236758134308);
            const double r = __builtin_fma(-kq, 6.123233995736766035868820147292e-17, __builtin_fma(-kq, 1.57079632679489661923, x));
            double s, c; sincos_pi4(r, s, c);
            const int qd = ((int)kq) & 3;
            const double cs = (qd == 0) ? c : (qd == 1) ? -s : (qd == 2) ? -c : s;
            const double sn = (qd == 0) ? s : (qd == 1) ? c : (qd == 2) ? -s : -c;
            rope[gt] = make_float2((float)cs, (float)sn);
        }
        { LAS float* sc = (LAS float*)lds; LAS float* red = (LAS float*)(lds + 40960);
          for (int i = tid; i < NSEQ * DM; i += 512) { const int b = i >> 11, k = i & (DM - 1); const float c = (b < 4) ? a.in[I_CP][b * DM + k] : a.in[I_CS][k]; sc[i] = c / (1.0f + __expf(-c)); }
          __syncthreads();
          const int cg = tid & 15, kg = tid >> 4;
          for (int item = bx; item < DEPTH * 192; item += G) {
              const int l = item / 192, n0 = (item % 192) * 64;
              const float* w = a.in[I_WMOD] + (size_t)l * DM * NMOD + n0 + cg * 4;
              f32x4 acc[NSEQ];
#pragma unroll
              for (int b = 0; b < NSEQ; ++b) acc[b] = (f32x4){0.f, 0.f, 0.f, 0.f};
#pragma unroll 8
              for (int i = 0; i < 64; ++i) { const int k = kg + 32 * i; const f32x4 wv = __builtin_nontemporal_load((const f32x4*)(w + (size_t)k * NMOD));
#pragma unroll
                  for (int b = 0; b < NSEQ; ++b) acc[b] = acc[b] + wv * sc[b * DM + k]; }
#pragma unroll
              for (int b = 0; b < NSEQ; ++b) *(LAS f32x4*)(red + (kg * NSEQ + b) * 64 + cg * 4) = acc[b];
              __syncthreads();
              if (tid < NSEQ * 64) { const int b = tid >> 6, n = tid & 63; float s = 0.f;
#pragma unroll 8
                  for (int k2 = 0; k2 < 32; ++k2) s += red[(k2 * NSEQ + b) * 64 + n];
                  float mv = s + a.in[I_BMOD][l * NMOD + n0 + n]; const int col = n0 + n, jj = col >> 11;
                  if (jj == 1) mv = (mv + 1.0f) * a.in[I_NMIX][l * DM + (col & (DM - 1))]; else if (jj == 4) mv = (mv + 1.0f) * a.in[I_NFFN][l * DM + (col & (DM - 1))];
                  mod[(size_t)(l * NSEQ + b) * NMOD + col] = mv; }
              __syncthreads();
          } }
            __syncthreads();
        { LAS float* scr = (LAS float*)(lds + wave * 8448);
          constexpr int I_IN = 32 * 144, I_OUT = 32 * 64, I_GU = 32 * 352, I_DN = 88 * 64, I_L = I_IN + I_OUT + I_GU + I_DN;
          for (int it = gw; it < DEPTH * I_L; it += NGW) {
              const int l = it / I_L; int r = it % I_L;
              if (r < I_IN) { convert_item<1>(a.in[I_WIN] + (size_t)l * DM * INW, INW, DM, Win_t + (size_t)l * INW * DM, r / 144, r % 144, scr, lane); continue; } r -= I_IN;
              if (r < I_OUT) { convert_item<3>(a.in[I_WOUT] + (size_t)l * DM * DM, DM, DM, Wout_t + (size_t)l * DM * DM, r / 64, r % 64, scr, lane); continue; } r -= I_OUT;
              if (r < I_GU) { convert_item<2>(a.in[I_WGU] + (size_t)l * DM * 2 * FF, 2 * FF, DM, Wgu_t + (size_t)l * 2 * FF * DM, r / 352, r % 352, scr, lane); continue; } r -= I_GU;
              convert_item<3>(a.in[I_WDN] + (size_t)l * FF * DM, DM, FF, Wdn_t + (size_t)l * DM * FF, r / 64, r % 64, scr, lane);
          } }
}
    SEAM(0);

    for (int l = 0; l < DEPTH; ++l) {
        const int p0 = 1 + 8 * l;
        const float* modl = mod + (size_t)l * NSEQ * NMOD;
#define NORM_PHASE(WHICH) do { \
            int lane = threadIdx.x & 63; asm volatile("" : "+v"(lane)); \
            const bool f32src = (l == 0 && !(WHICH)); \
            _Pragma("unroll 1") for (int r = gw; r < M; r += NGW) { \
                const int b = seq_of_row(r); \
                const float* sv = modl + (size_t)b * NMOD + ((WHICH) ? 3 : 0) * DM; const float* cv = sv + DM; \
                f32x4 v[4][2]; float ss = 0.f; \
                if (f32src) { const float* xr = ((r < MP) ? a.in[I_XP] + (size_t)r * DM : a.in[I_XS] + (size_t)(r - MP) * DM) + lane * 8; \
                    _Pragma("unroll") for (int j = 0; j < 4; ++j) { v[j][0] = *(const f32x4*)(xr + 512 * j); v[j][1] = *(const f32x4*)(xr + 512 * j + 4); } } \
                else { const bf16* xr = XB + (size_t)r * DM + lane * 8; \
                    _Pragma("unroll") for (int j = 0; j < 4; ++j) { const u32x4 w = __builtin_nontemporal_load((const u32x4*)(xr + 512 * j)); \
                        v[j][0] = (f32x4){__uint_as_float(w.x << 16), __uint_as_float(w.x & 0xffff0000u), __uint_as_float(w.y << 16), __uint_as_float(w.y & 0xffff0000u)}; \
                        v[j][1] = (f32x4){__uint_as_float(w.z << 16), __uint_as_float(w.z & 0xffff0000u), __uint_as_float(w.w << 16), __uint_as_float(w.w & 0xffff0000u)}; } } \
                _Pragma("unroll") for (int j = 0; j < 4; ++j) _Pragma("unroll") for (int h2 = 0; h2 < 2; ++h2) ss += (v[j][h2][0] * v[j][h2][0] + v[j][h2][1] * v[j][h2][1]) + (v[j][h2][2] * v[j][h2][2] + v[j][h2][3] * v[j][h2][3]); \
                const float rstd = 1.0f / sqrtf(wave_sum(ss) * (1.0f / DM) + 1e-6f); \
                bf16* orow = Hb + (size_t)r * DM + lane * 8; \
                _Pragma("unroll") for (int j = 0; j < 4; ++j) { f32x4 y[2]; \
                    _Pragma("unroll") for (int h2 = 0; h2 < 2; ++h2) { const int e = 512 * j + lane * 8 + 4 * h2; const f32x4 c4 = *(const f32x4*)(cv + e), s4 = *(const f32x4*)(sv + e); \
                        y[h2] = v[j][h2] * rstd * c4 + s4; } \
                    u32x4 w; w.x = cvtpk(y[0][0], y[0][1]); w.y = cvtpk(y[0][2], y[0][3]); w.z = cvtpk(y[1][0], y[1][1]); w.w = cvtpk(y[1][2], y[1][3]); *(u32x4*)(orow + 512 * j) = w; } \
            } } while (0)
        if (IN(p0) && !SKIP_NORM) { for (int rep = 0; rep < REP_NORM; ++rep) NORM_PHASE(0); }
        SEAM(p0);
        if (IN(p0 + 1) && !SKIP_GIN) for (int rep = 0; rep < REP_GIN; ++rep) {
            pg8::Gemm g{Hb, Win_t + (size_t)l * INW * DM, M, INW, DM}; pg8::StaticOrder S; S.init(M, INW, G, bx);
            pg8::EpiQKV E{QKV, a.in[I_QKG] + l * 512, rope};
            pg8::gemm_phase<pg8::EpiQKV>(lds, g, S, E);
        }
        SEAM(p0 + 1);
        if (IN(p0 + 2) && !SKIP_ATT) for (int rep = 0; rep < (ATT_REP_MASK ? 2 : REP_ATT); ++rep) {
            const float* relpos = a.in[I_RELPOS];
            const int NU = 4608;
#define QKB(mx) (((const LAS float*)(lds + MISC_OFF))[64 + 4 * l + (mx)])
#define BIASMAX(col) (((const LAS float*)(lds + MISC_OFF))[80 + (col)])
            for (int U = vcu; U < NU; U += G) {
                if (ATT_REP_MASK && rep == 1) { const int cls = (U < 1536) ? (((U < 256) || (U >= 512 && U < 1024)) ? 1 : 2) : (U < 2304 ? 4 : 8); if (!(ATT_REP_MASK & cls)) continue; }
                att::AU u; u.res = 0; u.mfix = 0.f; u.rs = INW; u.lse = nullptr; u.lrs = 0; u.sink4 = 0; u.has_sink = 0; u.wsh = 3; u.W = 0; u.hcol = 0; u.rmul = 1; u.of32 = 0;
                if (U < 1536) {
                    int s, hh, qb, isC;
                    if (U < 256) { isC = 1; s = 4; hh = U >> 5; qb = U & 31; }
                    else if (U < 512) { const int i = U - 256; isC = 0; s = 4; hh = i >> 5; qb = i & 31; }
                    else if (U < 1024) { const int i = U - 512; isC = 1; s = i >> 7; hh = (i >> 4) & 7; qb = i & 15; }
                    else { const int i = U - 1024; isC = 0; s = i >> 7; hh = (i >> 4) & 7; qb = i & 15; }
                    const int rb = (s < 4) ? s * TP : MP, T = (s < 4) ? TP : TS;
                    const bf16* base = QKV + (size_t)rb * INW;
                    u.q0 = qb * 256; u.kv0 = 0; u.nt = T / 64;
                    if (isC) { u.q = base + C_QC + 64 * hh; u.k = base + C_KC + 64 * hh; u.v = base + C_VC + 128 * (hh >> 1); u.hcol = 16 + (hh >> 1);
                               u.o = CSC + ((size_t)rb * 8 + hh) * 128; u.ors = 1024; u.mfix = QKB(2) + BIASMAX(16 + (hh >> 1)); att::attn_dense<1>(u, lds, relpos); }
                    else { u.q = base + C_QD + 64 * hh; u.k = base + C_KD + 64 * (hh >> 2); u.v = base + C_VD + 64 * (hh >> 2);
                           u.o = MIX + (size_t)rb * DM + 1536 + 64 * hh; u.ors = DM; u.mfix = QKB(3); att::attn_dense<0>(u, lds, relpos); }
                } else if (U < 2304) {
                    const int i = U - 1536; int s, kvh, qb;
                    if (i < 512) { s = i >> 7; kvh = (i >> 6) & 1; qb = i & 63; } else { const int i2 = i - 512; s = 4; kvh = i2 >> 7; qb = i2 & 127; }
                    const int rb = (s < 4) ? s * TP : MP, T = (s < 4) ? TP : TS;
                    const bf16* base = QKV + (size_t)rb * INW;
                    u.q = base + C_QA + 256 * kvh; u.k = base + C_KA + 64 * kvh; u.v = base + C_VA + 64 * kvh;
                    u.q0 = qb * 64; u.W = 128; u.hcol = 4 * kvh; u.rmul = 1; u.wsh = 1;
                    int k0 = u.q0 - 128, k1 = u.q0 + 192; if (k0 < 0) k0 = 0; if (k1 > T) k1 = T;
                    if (((k1 - k0) >> 6) & 1) { if (k1 + 64 <= T) k1 += 64; else k0 -= 64; }
                    u.kv0 = k0; u.nt = (k1 - k0) / 64; u.res = u.nt < 5 ? u.nt : 5;
                    u.o = MIX + (size_t)rb * DM + 256 * kvh; u.ors = DM;
                    u.sink4 = 8 * l + 4 * kvh; u.has_sink = 1;
                    u.mfix = QKB(0) + fmaxf(fmaxf(BIASMAX(4 * kvh), BIASMAX(4 * kvh + 1)), fmaxf(BIASMAX(4 * kvh + 2), BIASMAX(4 * kvh + 3)));
                    att::attn_dense<2>(u, lds, relpos);
                } else {
                    const int i = U - 2304; const int pat = i / 768, rem = i % 768, hh = rem / 96, r2 = rem % 96;
                    const int rr = (pat == 0) ? 1 : (pat == 1) ? 4 : 16;
                    int s, rho, qb;
                    if (r2 < 64) { s = r2 >> 4; const int w = r2 & 15, nb = 16 / rr; rho = w / nb; qb = w % nb; }
                    else { s = 4; const int w = r2 - 64, nb = 32 / rr; rho = w / nb; qb = w % nb; }
                    const int rb = (s < 4) ? s * TP : MP, T = (s < 4) ? TP : TS, L = T / rr;
                    const bf16* base = QKV + (size_t)(rb + rho) * INW;
                    u.q = base + C_QB + 64 * hh; u.k = base + C_KB + 64 * hh; u.v = base + C_VB + 64 * hh; u.rs = (long)rr * INW;
                    u.q0 = qb * 256; u.W = 64; u.hcol = 8 + hh; u.rmul = rr; u.wsh = 3; u.res = 3;
                    int k0 = u.q0 - 64, k1 = u.q0 + 320; if (k0 < 0) k0 = 0; if (k1 > L) k1 = L;
                    if (((k1 - k0) >> 6) & 1) { if (k1 + 64 <= L) k1 += 64; else k0 -= 64; }
                    u.kv0 = k0; u.nt = (k1 - k0) / 64;
                    u.o = BSC + ((size_t)pat * M + rb + rho) * 512 + 64 * hh; u.ors = (long)rr * 512;
                    u.lse = BLSE + ((size_t)pat * M + rb + rho) * 8 + hh; u.lrs = (long)rr * 8;
                    u.mfix = QKB(1) + BIASMAX(8 + hh);
                    att::attn_dense<2>(u, lds, relpos);
                }
            }
        }
        SEAM(p0 + 2);
        if (IN(p0 + 3) && !SKIP_CMB) for (int rep = 0; rep < REP_CMB; ++rep) {
            int lane = threadIdx.x & 63; asm volatile("" : "+v"(lane));
            const float lam_init = 0.8f - 0.6f * expf(-0.3f * (float)l);
            const float* dl = a.in[I_DLAM] + l * 256;
            const float s1 = wave_sum(dl[lane] * dl[64 + lane]), s2 = wave_sum(dl[128 + lane] * dl[192 + lane]);
            const float lam = expf(s1) - expf(s2) + lam_init;
            const float* sub = a.in[I_DSUB] + l * 128;
            const int hC = lane >> 4, dC = (lane & 15) * 8, hB = lane >> 3, dB = (lane & 7) * 8;
            const f32x4 sg0 = *(const f32x4*)(sub + dC) * (1.0f - lam_init), sg1 = *(const f32x4*)(sub + dC + 4) * (1.0f - lam_init);
            for (int r = gw; r < M; r += NGW) {
                { const bf16* p0_ = CSC + ((size_t)r * 8 + hC * 2) * 128 + dC; const u32x4 w0 = __builtin_nontemporal_load((const u32x4*)p0_), w1 = __builtin_nontemporal_load((const u32x4*)(p0_ + 128));
                  float a[8];
#pragma unroll
                  for (int j = 0; j < 4; ++j) { a[2 * j] = __uint_as_float(w0[j] << 16) - lam * __uint_as_float(w1[j] << 16); a[2 * j + 1] = __uint_as_float(w0[j] & 0xffff0000u) - lam * __uint_as_float(w1[j] & 0xffff0000u); }
                  float ss = 0.f;
#pragma unroll
                  for (int j = 0; j < 8; ++j) ss += a[j] * a[j];
                  ss += __shfl_xor(ss, 1); ss += __shfl_xor(ss, 2); ss += __shfl_xor(ss, 4); ss += __shfl_xor(ss, 8);
                  const float rstd = 1.0f / sqrtf(ss * (1.0f / 128.0f) + 1e-6f);
                  u32x4 w; w.x = cvtpk(a[0] * rstd * sg0[0], a[1] * rstd * sg0[1]); w.y = cvtpk(a[2] * rstd * sg0[2], a[3] * rstd * sg0[3]);
                  w.z = cvtpk(a[4] * rstd * sg1[0], a[5] * rstd * sg1[1]); w.w = cvtpk(a[6] * rstd * sg1[2], a[7] * rstd * sg1[3]);
                  *(u32x4*)(MIX + (size_t)r * DM + 1024 + hC * 128 + dC) = w; }
                { const float e0 = BLSE[((size_t)0 * M + r) * 8 + hB], e1 = BLSE[((size_t)1 * M + r) * 8 + hB], e2 = BLSE[((size_t)2 * M + r) * 8 + hB];
                  const float mx = fmaxf(e0, fmaxf(e1, e2));
                  float w0 = __builtin_amdgcn_exp2f(e0 - mx), w1 = __builtin_amdgcn_exp2f(e1 - mx), w2 = __builtin_amdgcn_exp2f(e2 - mx);
                  const float iw = 1.0f / (w0 + w1 + w2); w0 *= iw; w1 *= iw; w2 *= iw;
                  const u32x4 q0_ = __builtin_nontemporal_load((const u32x4*)(BSC + ((size_t)0 * M + r) * 512 + hB * 64 + dB)), q1_ = __builtin_nontemporal_load((const u32x4*)(BSC + ((size_t)1 * M + r) * 512 + hB * 64 + dB)), q2_ = __builtin_nontemporal_load((const u32x4*)(BSC + ((size_t)2 * M + r) * 512 + hB * 64 + dB));
                  u32x4 w;
#pragma unroll
                  for (int j = 0; j < 4; ++j) {
                      const float lo = __uint_as_float(q0_[j] << 16) * w0 + __uint_as_float(q1_[j] << 16) * w1 + __uint_as_float(q2_[j] << 16) * w2;
                      const float hi2 = __uint_as_float(q0_[j] & 0xffff0000u) * w0 + __uint_as_float(q1_[j] & 0xffff0000u) * w1 + __uint_as_float(q2_[j] & 0xffff0000u) * w2;
                      w[j] = cvtpk(lo, hi2); }
                  *(u32x4*)(MIX + (size_t)r * DM + 512 + hB * 64 + dB) = w; }
            }
        }
        SEAM(p0 + 3);
        if (IN(p0 + 4) && !SKIP_GOUT) for (int rep = 0; rep < REP_GRES; ++rep) {
            pg8::Gemm g{MIX, Wout_t + (size_t)l * DM * DM, M, DM, DM}; pg8::StaticOrder S; S.init(M, DM, G, bx);
            const int s32 = (l == 0 && rep == 0) ? 1 : 0;
            pg8::EpiResid E{XB, s32 ? (const void*)a.in[I_XP] : (const void*)XB, s32 ? (const void*)a.in[I_XS] : (const void*)(XB + (size_t)MP * DM), modl + 2 * DM, rep == 0 ? 1.0f : 0.0f, s32, 0, 0};
            pg8::gemm_phase<pg8::EpiResid>(lds, g, S, E);
        }
        SEAM(p0 + 4);
        if (IN(p0 + 5) && !SKIP_NORM) { for (int rep = 0; rep < REP_NORM; ++rep) NORM_PHASE(1); }
        SEAM(p0 + 5);
        if (IN(p0 + 6) && !SKIP_GGU) for (int rep = 0; rep < REP_GGU; ++rep) {
            pg8::Gemm g{Hb, Wgu_t + (size_t)l * 2 * FF * DM, M, 2 * FF, DM}; pg8::StaticOrder S; S.init(M, 2 * FF, G, bx);
            pg8::EpiSwiglu E{ACT};
            pg8::gemm_phase<pg8::EpiSwiglu>(lds, g, S, E);
        }
        SEAM(p0 + 6);
        if (IN(p0 + 7) && !SKIP_GDN) for (int rep = 0; rep < REP_GRES; ++rep) {
            pg8::Gemm g{ACT, Wdn_t + (size_t)l * DM * FF, M, DM, FF}; pg8::StaticOrder S; S.init(M, DM, G, bx);
            const int d32 = (l + 1 == DEPTH) ? 1 : 0;
            pg8::EpiResid E{d32 ? (void*)X : (void*)XB, XB, XB + (size_t)MP * DM, modl + 5 * DM, rep == 0 ? 1.0f : 0.0f, 0, d32, 0};
            pg8::gemm_phase<pg8::EpiResid>(lds, g, S, E);
        }
        SEAM(p0 + 7);
    }
#undef IN
#undef SEAM
#undef NORM_PHASE
}

extern "C" void kernel_launch(void* const* d_in, const int* in_sizes, int n_in, void* d_out, int out_size, void* d_ws, size_t ws_size, hipStream_t stream) {
    static int grid = 0;
    if (grid == 0) {
        if (n_in != 17 || out_size != M * DM || ws_size < WS_END) { fprintf(stderr, "kernel_launch: unexpected shapes (n_in %d out %d ws %zu)\n", n_in, out_size, ws_size); grid = -1; return; }
        int dev = 0, cus = 0, per_cu = 0;
        if (hipGetDevice(&dev) != hipSuccess || hipDeviceGetAttribute(&cus, hipDeviceAttributeMultiprocessorCount, dev) != hipSuccess) { grid = -1; return; }
        if (hipFuncSetAttribute((const void*)mega_fwd, hipFuncAttributeMaxDynamicSharedMemorySize, LDS_BYTES) != hipSuccess) { fprintf(stderr, "kernel_launch: hipFuncSetAttribute failed\n"); grid = -1; return; }
        if (hipOccupancyMaxActiveBlocksPerMultiprocessor(&per_cu, (const void*)mega_fwd, 512, LDS_BYTES) != hipSuccess || per_cu < 1) { fprintf(stderr, "kernel_launch: occupancy query says %d\n", per_cu); }
        (void)hipGetLastError();
        grid = cus;
    }
    if (grid < 0) return;
    (void)hipMemsetAsync((char*)d_ws + WS_CTL, 0, CTL_ZERO_BYTES, stream);
    Args a{};
    for (int i = 0; i < 17; ++i) a.in[i] = (const float*)d_in[i];
    a.out = (float*)d_out; a.ws = (unsigned char*)d_ws;
    const int NPH = 1 + 8 * DEPTH;
#if MK_PER_PHASE
    for (int p = 0; p < NPH; ++p) { a.ph_lo = p; a.ph_hi = p + 1; hipLaunchKernelGGL(mega_fwd, dim3(grid), dim3(512), LDS_BYTES, stream, a); }
#else
    a.ph_lo = 0; a.ph_hi = NPH;
    hipLaunchKernelGGL(mega_fwd, dim3(grid), dim3(512), LDS_BYTES, stream, a);
#endif
}
```

```cpp
#include <hip/hip_runtime.h>
#include <cstdio>
#include <cstdint>

#ifndef MK_PER_PHASE
#define MK_PER_PHASE 0
#endif


#ifndef SKIP_PRO
#define SKIP_PRO 0
#endif
#ifndef SKIP_NORM
#define SKIP_NORM 0
#endif
#ifndef SKIP_GIN
#define SKIP_GIN 0
#endif
#ifndef SKIP_ATT
#define SKIP_ATT 0
#endif
#ifndef SKIP_CMB
#define SKIP_CMB 0
#endif
#ifndef SKIP_GOUT
#define SKIP_GOUT 0
#endif
#ifndef SKIP_GGU
#define SKIP_GGU 0
#endif
#ifndef SKIP_GDN
#define SKIP_GDN 0
#endif

#ifndef REP_NORM
#define REP_NORM 1
#endif
#ifndef REP_GIN
#define REP_GIN 1
#endif
#ifndef REP_ATT
#define REP_ATT 1
#endif
#ifndef REP_CMB
#define REP_CMB 1
#endif
#ifndef REP_GRES
#define REP_GRES 1
#endif
#ifndef REP_PRO
#define REP_PRO 1
#endif
#ifndef ATT_REP_MASK
#define ATT_REP_MASK 0
#endif
#ifndef REP_GGU
#define REP_GGU 1
#endif
#define GAS __attribute__((address_space(1)))
#define LAS __attribute__((address_space(3)))
typedef unsigned short bf16;
typedef short bf16x8 __attribute__((ext_vector_type(8)));
typedef short s16x4 __attribute__((ext_vector_type(4)));
typedef float f32x2 __attribute__((ext_vector_type(2)));
typedef float f32x4 __attribute__((ext_vector_type(4)));
typedef float f32x16 __attribute__((ext_vector_type(16)));
typedef unsigned u32x2 __attribute__((ext_vector_type(2)));
typedef unsigned u32x4 __attribute__((ext_vector_type(4)));
typedef __bf16 bf16x2_t __attribute__((ext_vector_type(2)));

constexpr int DM = 2048, TP = 4096, TS = 8192, MP = 16384, M = 24576, DEPTH = 4, NSEQ = 5;
constexpr int INW = 4608, FF = 5632, NMOD = 12288;
constexpr int C_QA = 0, C_KA = 512, C_VA = 640, C_QB = 768, C_KB = 1280, C_VB = 1792, C_QC = 2304, C_KC = 2816, C_VC = 3328, C_QD = 3840, C_KD = 4352, C_VD = 4480;
constexpr float LOG2E = 1.4426950408889634f;
constexpr float QSCALE = 0.125f * LOG2E;
constexpr float NEG_BIG = -1e30f, M_INIT = -30000.f;

constexpr size_t MiB = 1u << 20;
constexpr size_t WS_CTL = 0, CTL_ZERO_BYTES = 64 * 1024;
constexpr size_t WS_MOD = 1 * MiB;
constexpr size_t WS_ROPE = 2 * MiB;
constexpr size_t WS_WIN = 4 * MiB;
constexpr size_t WS_WOUT = 76 * MiB;
constexpr size_t WS_WGU = 108 * MiB;
constexpr size_t WS_WDN = 284 * MiB;
constexpr size_t WS_H = 372 * MiB;
constexpr size_t WS_QKV = 468 * MiB;
constexpr size_t WS_MIX = 684 * MiB;
constexpr size_t WS_BSC = 780 * MiB;
constexpr size_t WS_BLSE = 852 * MiB;
constexpr size_t WS_CSC = 855 * MiB;
constexpr size_t WS_XB = 903 * MiB;
constexpr size_t WS_ACT = 999 * MiB;
constexpr size_t WS_END = 1263 * MiB;
constexpr int CW_BAR = 1024;

constexpr int RING_BYTES = 131072;
constexpr int MISC_OFF = RING_BYTES;
constexpr int LDS_BYTES = 147456;

__device__ __forceinline__ unsigned cvtpk(float lo, float hi) { f32x2 v = {lo, hi}; bf16x2_t b = __builtin_convertvector(v, bf16x2_t); return __builtin_bit_cast(unsigned, b); }
__device__ __forceinline__ float wave_sum(float v) {
#pragma unroll
    for (int o = 1; o < 64; o <<= 1) v += __shfl_xor(v, o);
    return v;
}
__device__ __forceinline__ int seq_of_row(int r) { return r < MP ? (r >> 12) : 4; }
__device__ __forceinline__ int pos_of_row(int r) { return r < MP ? (r & (TP - 1)) : (r - MP); }

#define XB_TMO      128
#define XB_XCNT(j)  (256  + 64 * (j))
#define XB_XSUB(j)  (1280 + 64 * (j))
#define XB_XGEN(j)  (2304 + 64 * (j))
#define XB_TOP      3328
#define XB_TOPGEN   3392
#define XCD_BAR_WORDS 3456
#define XB_SPIN_CAP (1u << 18)
__device__ __forceinline__ unsigned xb_ld(unsigned* p)              { return __hip_atomic_load(p, __ATOMIC_RELAXED, __HIP_MEMORY_SCOPE_AGENT); }
__device__ __forceinline__ unsigned xb_add(unsigned* p, unsigned v) { return __hip_atomic_fetch_add(p, v, __ATOMIC_RELAXED, __HIP_MEMORY_SCOPE_AGENT); }
__device__ __forceinline__ unsigned xb_xcc_id() { return (unsigned)__builtin_amdgcn_s_getreg((3 << 11) | 20) & 0xFu; }
#define XB_SPIN(cond, bar) do { unsigned _sp = 0; while (cond) { __builtin_amdgcn_s_sleep(1); \
    if ((++_sp & 255u) == 0u) { if (xb_ld(&(bar)[XB_TMO])) break; if (_sp > XB_SPIN_CAP) { atomicAdd(&(bar)[XB_TMO], 1u); break; } } } } while (0)
struct XcdBarrier { unsigned* bar; unsigned x; volatile LAS unsigned* st; };
__device__ __forceinline__ XcdBarrier xcd_barrier_post(unsigned* bar, volatile LAS unsigned* st) {
    XcdBarrier b; b.bar = bar; b.x = xb_xcc_id(); b.st = st;
    if (threadIdx.x == 0) (void)xb_add(&bar[XB_XCNT(b.x)], 1u);
    return b;
}
__device__ __forceinline__ void xcd_barrier_complete(unsigned* bar, unsigned x, unsigned& nloc, unsigned& nx) {
    const unsigned G = gridDim.x * gridDim.y * gridDim.z;
    unsigned sum, cnt, mine, sp = 0u;
    for (;;) {
        sum = 0u; cnt = 0u; mine = 0u;
#pragma unroll
        for (unsigned j = 0; j < 16; ++j) { const unsigned c = xb_ld(&bar[XB_XCNT(j)]); sum += c; cnt += (c > 0u) ? 1u : 0u; mine = (j == x) ? c : mine; }
        if (sum == G) break;
        __builtin_amdgcn_s_sleep(1);
        if ((++sp & 255u) == 0u) { if (xb_ld(&bar[XB_TMO])) break; if (sp > XB_SPIN_CAP) { atomicAdd(&bar[XB_TMO], 1u); break; } }
    }
    nloc = mine > 0u ? mine : 1u; nx = cnt > 0u ? cnt : 1u;
}
__device__ __forceinline__ void xcd_barrier(const XcdBarrier& b) {
    asm volatile("s_waitcnt vmcnt(0)" ::: "memory");
    __syncthreads();
    if (threadIdx.x == 0) {
        unsigned* bar = b.bar;
        __builtin_amdgcn_s_waitcnt(0);
        unsigned nloc = b.st[0], nx = b.st[1];
        if (nloc == 0u) { xcd_barrier_complete(bar, b.x, nloc, nx); b.st[0] = nloc; b.st[1] = nx; }
        const unsigned old = xb_add(&bar[XB_XSUB(b.x)], 1u);
        const unsigned gen = old / nloc;
        if (old + 1u == (gen + 1u) * nloc) {
            __builtin_amdgcn_fence(__ATOMIC_RELEASE, "agent");
            asm volatile("s_waitcnt vmcnt(0)" ::: "memory");
            const unsigned og = xb_add(&bar[XB_TOP], 1u);
            const unsigned tg = og / nx;
            if (og + 1u == (tg + 1u) * nx) xb_add(&bar[XB_TOPGEN], 1u);
            else XB_SPIN(xb_ld(&bar[XB_TOPGEN]) == tg, bar);
            __builtin_amdgcn_fence(__ATOMIC_ACQUIRE, "agent");
            xb_add(&bar[XB_XGEN(b.x)], 1u);
            asm volatile("s_waitcnt vmcnt(0)" ::: "memory");
        } else {
            XB_SPIN(xb_ld(&bar[XB_XGEN(b.x)]) == gen, bar);
            __builtin_amdgcn_fence(__ATOMIC_ACQUIRE, "agent");
            asm volatile("s_waitcnt vmcnt(0)" ::: "memory");
        }
    }
    __syncthreads();
}

namespace pg8 {
constexpr int BM = 256, BK = 64, HALF = 128, HTB = HALF * BK * 2, STAGE_BYTES = 8 * HTB, NXCD = 8, WGM = 4;
__host__ __device__ __forceinline__ int lds_byte(int r, int c) { const int st = (r >> 4) * 2 + (c >> 5), rr = r & 15, cc = c & 31, ob = rr * 64 + cc * 2; return st * 1024 + (ob ^ (((ob >> 9) & 1) << 5)); }
__host__ __device__ __forceinline__ void stage_rc(int b, int& R, int& C) { const int st = b / 1024, sb = b % 1024, swz = sb ^ (((sb >> 9) & 1) << 5); R = (st >> 1) * 16 + swz / 64; C = (st & 1) * 32 + (swz % 64) / 2; }
struct Unit { int pm, pn; };
struct Gemm { const bf16* A; const bf16* Bt; int M, N, K; };
struct StaticOrder {
    int nM, nN, nwg, G, c, lim;
    __host__ __device__ void init(int M_, int N_, int G_, int c_) { nM = M_ / BM; nN = N_ / BM; nwg = nM * nN; G = G_; c = c_; lim = nwg; }
    __host__ __device__ bool next(int i, Unit& u) const {
        const long L = (long)i * G + c; if (L >= lim) return false;
        int wgid = (int)L; { const int q = nwg / NXCD, r = nwg % NXCD, xcd = wgid % NXCD, off = wgid / NXCD; wgid = (xcd < r ? xcd * (q + 1) : r * (q + 1) + (xcd - r) * q) + off; }
        const int nig = WGM * nN, gid = wgid / nig, fm = gid * WGM, gsz = (nM - fm) < WGM ? (nM - fm) : WGM;
        u.pm = fm + ((wgid % nig) % gsz); u.pn = (wgid % nig) / gsz; return true;
    }
};
template <class Epi, int HSEL = -1>
__device__ __forceinline__ void gemm_phase(LAS unsigned char* lds, const Gemm g, const StaticOrder& S, const Epi& E) {
    int tid = threadIdx.x; asm volatile("" : "+v"(tid));
    const int wid = __builtin_amdgcn_readfirstlane(tid >> 6), lane = tid & 63, wr = wid >> 2, wc = wid & 3, fr = lane & 15, fq = lane >> 4;
    const int K = g.K, nt = K / BK;
    unsigned voffA[2];
#pragma unroll
    for (int i = 0; i < 2; ++i) { int R, C; stage_rc(tid * 16 + i * 8192, R, C); voffA[i] = (unsigned)(R * K + C) * 2u; }
    const size_t kstep = (size_t)(BK * 2);
    const size_t hstep = (size_t)HALF * K * 2;
    const size_t tstep = 2 * hstep;
    const unsigned ldsw = (unsigned)wid * 1024u;
    const int aoff = lds_byte(wr * 64 + fr, fq * 8), boff = lds_byte(wc * 32 + fr, fq * 8);
#define PG8_SA(b, h) (((b) * 2 + (h)) * HTB)
#define PG8_SB(b, h) ((4 + (b) * 2 + (h)) * HTB)
#define PG8_STAGE(bufoff, gbase) do { _Pragma("unroll") for (int _i = 0; _i < 2; ++_i) \
        __builtin_amdgcn_global_load_lds((const unsigned*)((const char*)(gbase) + voffA[_i]), (LAS unsigned*)(lds + (bufoff) + ldsw + _i * 8192), 16, 0, 0); } while (0)
#define PG8_LDA(dst, b, h) do { _Pragma("unroll") for (int m = 0; m < 4; ++m) _Pragma("unroll") for (int k = 0; k < 2; ++k) dst[m][k] = *(const LAS bf16x8*)(lds + PG8_SA(b, h) + aoff + m * 2048 + k * 1024); } while (0)
#define PG8_LDB(dst, b, h) do { _Pragma("unroll") for (int n = 0; n < 2; ++n) _Pragma("unroll") for (int k = 0; k < 2; ++k) dst[n][k] = *(const LAS bf16x8*)(lds + PG8_SB(b, h) + boff + n * 2048 + k * 1024); } while (0)
#define PG8_MMA(ai, bj, At, Bt) do { __builtin_amdgcn_s_setprio(1); _Pragma("unroll") for (int m = 0; m < 4; ++m) _Pragma("unroll") for (int n = 0; n < 2; ++n) _Pragma("unroll") for (int k = 0; k < 2; ++k) \
        acc[ai][bj][m][n] = __builtin_amdgcn_mfma_f32_16x16x32_bf16(Bt[n][k], At[m][k], acc[ai][bj][m][n], 0, 0, 0); __builtin_amdgcn_s_setprio(0); } while (0)
#define PG8_WAIT_V(n) asm volatile("s_waitcnt vmcnt(" #n ")" ::: "memory")
#define PG8_WAIT_L(n) asm volatile("s_waitcnt lgkmcnt(" #n ")" ::: "memory")
#define PG8_WAIT_VL do { if (HSEL < 0) PG8_WAIT_V(8); else PG8_WAIT_V(6); } while (0)
#define PG8_BAR __builtin_amdgcn_s_barrier()
#define PG8_SCHED __builtin_amdgcn_sched_barrier(0)
    Unit cur, nxt; int ui = 0;
    if (!S.next(0, cur)) return;
    f32x4 acc[2][2][4][2];
#pragma unroll
    for (int a = 0; a < 2; ++a)
#pragma unroll
        for (int b = 0; b < 2; ++b)
#pragma unroll
            for (int m = 0; m < 4; ++m)
#pragma unroll
                for (int n = 0; n < 2; ++n) acc[a][b][m][n] = (f32x4){0.f, 0.f, 0.f, 0.f};
    bf16x8 At[4][2], B0[2][2], B1[2][2];
    const char* cA = (const char*)g.A + (size_t)cur.pm * tstep; const char* cB = (const char*)g.Bt + (size_t)cur.pn * tstep;
    if (HSEL != 1) PG8_STAGE(PG8_SB(0, 0), cB); if (HSEL != 0) PG8_STAGE(PG8_SB(0, 1), cB + hstep); PG8_STAGE(PG8_SA(0, 0), cA); PG8_STAGE(PG8_SA(0, 1), cA + hstep);
    if (wr == 1) PG8_BAR;
    PG8_WAIT_V(2); PG8_BAR;
    if (HSEL != 1) PG8_STAGE(PG8_SB(1, 0), cB + kstep); PG8_STAGE(PG8_SA(1, 0), cA + kstep); if (HSEL != 0) PG8_STAGE(PG8_SB(1, 1), cB + hstep + kstep);
    if (HSEL < 0) PG8_WAIT_V(6); else PG8_WAIT_V(4); PG8_BAR;
    for (;;) {
        const bool has_next = S.next(ui + 1, nxt);
        const char* nA = has_next ? (const char*)g.A + (size_t)nxt.pm * tstep : cA; const char* nB = has_next ? (const char*)g.Bt + (size_t)nxt.pn * tstep : cB;
        for (int t = 0; t < nt; t += 2) {
            const bool last = (t == nt - 2);
            const char* a1 = cA + (size_t)(t + 1) * kstep;
            const char* a2 = last ? nA : cA + (size_t)(t + 2) * kstep; const char* b2 = last ? nB : cB + (size_t)(t + 2) * kstep;
            const char* a3 = a2 + kstep; const char* b3 = b2 + kstep;
            if (HSEL != 1) PG8_LDB(B0, 0, 0); if (HSEL != 0) PG8_LDB(B1, 0, 1); PG8_SCHED; PG8_LDA(At, 0, 0); PG8_STAGE(PG8_SA(1, 1), a1 + hstep);
            PG8_WAIT_VL; PG8_WAIT_L(0); PG8_BAR; if (HSEL != 1) PG8_MMA(0, 0, At, B0); if (HSEL != 0) PG8_MMA(0, 1, At, B1); PG8_BAR; PG8_SCHED;
            PG8_LDA(At, 0, 1); if (HSEL != 1) PG8_STAGE(PG8_SB(0, 0), b2); if (HSEL != 0) PG8_STAGE(PG8_SB(0, 1), b2 + hstep); PG8_STAGE(PG8_SA(0, 0), a2);
            PG8_WAIT_VL; PG8_WAIT_L(0); PG8_BAR; if (HSEL != 1) PG8_MMA(1, 0, At, B0); if (HSEL != 0) PG8_MMA(1, 1, At, B1); PG8_BAR; PG8_SCHED;
            if (HSEL != 1) PG8_LDB(B0, 1, 0); if (HSEL != 0) PG8_LDB(B1, 1, 1); PG8_SCHED; PG8_LDA(At, 1, 0); PG8_STAGE(PG8_SA(0, 1), a2 + hstep);
            PG8_WAIT_VL; PG8_WAIT_L(0); PG8_BAR; if (HSEL != 1) PG8_MMA(0, 0, At, B0); if (HSEL != 0) PG8_MMA(0, 1, At, B1); PG8_BAR; PG8_SCHED;
            PG8_LDA(At, 1, 1); if (HSEL != 1) PG8_STAGE(PG8_SB(1, 0), b3); if (HSEL != 0) PG8_STAGE(PG8_SB(1, 1), b3 + hstep); PG8_STAGE(PG8_SA(1, 0), a3);
            PG8_WAIT_VL; PG8_WAIT_L(0); PG8_BAR; if (HSEL != 1) PG8_MMA(1, 0, At, B0); if (HSEL != 0) PG8_MMA(1, 1, At, B1); PG8_BAR; PG8_SCHED;
        }
        if (wr == 0) PG8_BAR;
        E(acc, cur, wr, wc, fr, fq);
        if (!has_next) break;
#pragma unroll
        for (int a = 0; a < 2; ++a)
#pragma unroll
            for (int b = 0; b < 2; ++b)
#pragma unroll
                for (int m = 0; m < 4; ++m)
#pragma unroll
                    for (int n = 0; n < 2; ++n) acc[a][b][m][n] = (f32x4){0.f, 0.f, 0.f, 0.f};
        cur = nxt; cA = nA; cB = nB; ++ui;
        if (wr == 1) PG8_BAR;
    }
    PG8_WAIT_V(0);
    PG8_BAR;
#undef PG8_SA
#undef PG8_SB
#undef PG8_STAGE
#undef PG8_LDA
#undef PG8_LDB
#undef PG8_MMA
#undef PG8_WAIT_V
#undef PG8_WAIT_L
#undef PG8_WAIT_VL
#undef PG8_BAR
#undef PG8_SCHED
}

struct EpiQKV {
    bf16* O; const float* gains  ; const float2* rope  ;
    __device__ __forceinline__ void operator()(f32x4 (&acc)[2][2][4][2], const Unit& u, int wr, int wc, int fr, int fq) const {
        const int hg = u.pn * 4 + wc;
        int gi = -1; bool isq = false, rp = false;
        if (hg < 8) { gi = 0; isq = true; } else if (hg < 10) gi = 1; else if (hg < 12) gi = -1;
        else if (hg < 20) { gi = 2; isq = true; } else if (hg < 28) gi = 3; else if (hg < 36) gi = -1;
        else if (hg < 44) { gi = 4; isq = true; } else if (hg < 52) gi = 5; else if (hg < 60) gi = -1;
        else if (hg < 68) { gi = 6; isq = true; rp = true; } else if (hg < 70) { gi = 7; rp = true; }
        f32x4 gv[2][2];
#pragma unroll
        for (int bj = 0; bj < 2; ++bj)
#pragma unroll
            for (int n = 0; n < 2; ++n) { gv[bj][n] = (gi >= 0) ? *(const f32x4*)(gains + gi * 64 + 32 * (fq & 1) + 16 * n + 8 * (fq >> 1) + 4 * bj) : (f32x4){1.f, 1.f, 1.f, 1.f}; if (isq) gv[bj][n] = gv[bj][n] * QSCALE; }
#pragma unroll
        for (int ai = 0; ai < 2; ++ai)
#pragma unroll
            for (int m = 0; m < 4; ++m) {
                const int row = u.pm * BM + ai * HALF + wr * 64 + m * 16 + fr;
                f32x4 v[2][2];
#pragma unroll
                for (int bj = 0; bj < 2; ++bj)
#pragma unroll
                    for (int n = 0; n < 2; ++n) v[bj][n] = acc[ai][bj][m][n];
                float rstd = 1.f;
                if (gi >= 0) {
                    float ss = 0.f;
#pragma unroll
                    for (int bj = 0; bj < 2; ++bj)
#pragma unroll
                        for (int n = 0; n < 2; ++n) ss += (v[bj][n][0] * v[bj][n][0] + v[bj][n][1] * v[bj][n][1]) + (v[bj][n][2] * v[bj][n][2] + v[bj][n][3] * v[bj][n][3]);
                    ss += __shfl_xor(ss, 16); ss += __shfl_xor(ss, 32);
                    rstd = __builtin_amdgcn_rsqf(ss * (1.0f / 64.0f) + 1e-6f);
                }
#pragma unroll
                for (int bj = 0; bj < 2; ++bj)
#pragma unroll
                    for (int n = 0; n < 2; ++n) v[bj][n] = v[bj][n] * (gv[bj][n] * rstd);
                if (rp) {
                    const int t = pos_of_row(row);
                    const int pos = (fq & 1) ? (t & 63) : (t >> 6);
#pragma unroll
                    for (int bj = 0; bj < 2; ++bj) {
                        const float2* rp_ = rope + pos * 16 + 8 * (fq >> 1) + 4 * bj;
                        const f32x4 cs0 = *(const f32x4*)rp_, cs1 = *(const f32x4*)(rp_ + 2);
                        const float c[4] = {cs0[0], cs0[2], cs1[0], cs1[2]}, s[4] = {cs0[1], cs0[3], cs1[1], cs1[3]};
#pragma unroll
                        for (int i = 0; i < 4; ++i) { const float x1 = v[bj][0][i], x2 = v[bj][1][i]; v[bj][0][i] = x1 * c[i] - x2 * s[i]; v[bj][1][i] = x2 * c[i] + x1 * s[i]; }
                    }
                }
                bf16* rowp = O + (size_t)row * INW + hg * 64 + 32 * (fq & 1) + 8 * (fq >> 1);
#pragma unroll
                for (int n = 0; n < 2; ++n) { u32x4 w; w.x = cvtpk(v[0][n][0], v[0][n][1]); w.y = cvtpk(v[0][n][2], v[0][n][3]); w.z = cvtpk(v[1][n][0], v[1][n][1]); w.w = cvtpk(v[1][n][2], v[1][n][3]);
                    *(u32x4*)(rowp + 16 * n) = w; }
            }
    }
};
struct EpiResid {
    void* dst; const void* srcp; const void* srcs;
    const float* gate  ; float gsc; int src_f32, dst_f32, pad_;
    __device__ __forceinline__ void operator()(f32x4 (&acc)[2][2][4][2], const Unit& u, int wr, int wc, int fr, int fq) const {
        const int b = seq_of_row(u.pm * BM);
        const int col0 = u.pn * BM + wc * 32 + fq * 8;
        const float* gvec = gate + (size_t)b * (6 * DM) + col0;
        f32x4 gv[2][2];
#pragma unroll
        for (int bj = 0; bj < 2; ++bj)
#pragma unroll
            for (int n = 0; n < 2; ++n) gv[bj][n] = *(const f32x4*)(gvec + bj * HALF + n * 4) * gsc;
#pragma unroll
        for (int am = 0; am < 4; ++am) {
            const int ai = am >> 1;
            f32x4 xv[2][2][2];
#pragma unroll
            for (int mm = 0; mm < 2; ++mm) { const int m = (am & 1) * 2 + mm; const int row = u.pm * BM + ai * HALF + wr * 64 + m * 16 + fr;
                const size_t eo = ((row < MP) ? (size_t)row : (size_t)(row - MP)) * DM + col0;
                if (src_f32) { const float* rp = (const float*)((row < MP) ? srcp : srcs) + eo;
#pragma unroll
                    for (int bj = 0; bj < 2; ++bj)
#pragma unroll
                        for (int n = 0; n < 2; ++n) xv[mm][bj][n] = *(const f32x4*)(rp + bj * HALF + n * 4); }
                else { const bf16* rp = (const bf16*)((row < MP) ? srcp : srcs) + eo;
#pragma unroll
                    for (int bj = 0; bj < 2; ++bj) { const u32x4 w = *(const u32x4*)(rp + bj * HALF);
                        xv[mm][bj][0] = (f32x4){__uint_as_float(w.x << 16), __uint_as_float(w.x & 0xffff0000u), __uint_as_float(w.y << 16), __uint_as_float(w.y & 0xffff0000u)};
                        xv[mm][bj][1] = (f32x4){__uint_as_float(w.z << 16), __uint_as_float(w.z & 0xffff0000u), __uint_as_float(w.w << 16), __uint_as_float(w.w & 0xffff0000u)}; } }
            }
#pragma unroll
            for (int mm = 0; mm < 2; ++mm) { const int m = (am & 1) * 2 + mm; const size_t eo = (size_t)(u.pm * BM + ai * HALF + wr * 64 + m * 16 + fr) * DM + col0;
#pragma unroll
                for (int bj = 0; bj < 2; ++bj) { const f32x4 x0 = xv[mm][bj][0] + gv[bj][0] * acc[ai][bj][m][0], x1 = xv[mm][bj][1] + gv[bj][1] * acc[ai][bj][m][1];
                    if (dst_f32) { *(f32x4*)((float*)dst + eo + bj * HALF) = x0; *(f32x4*)((float*)dst + eo + bj * HALF + 4) = x1; }
                    else { u32x4 w; w.x = cvtpk(x0[0], x0[1]); w.y = cvtpk(x0[2], x0[3]); w.z = cvtpk(x1[0], x1[1]); w.w = cvtpk(x1[2], x1[3]); *(u32x4*)((bf16*)dst + eo + bj * HALF) = w; } }
            }
            asm volatile("" ::: "memory");
        }
    }
};
struct EpiSwiglu {
    bf16* O; int hsel, pad_;
    __device__ __forceinline__ void operator()(f32x4 (&acc)[2][2][4][2], const Unit& u, int wr, int wc, int fr, int fq) const {
#pragma unroll
        for (int ai = 0; ai < 2; ++ai)
#pragma unroll
            for (int m = 0; m < 4; ++m) {
                const int row = u.pm * BM + ai * HALF + wr * 64 + m * 16 + fr;
                float a[2][4];
#pragma unroll
                for (int bj = 0; bj < 2; ++bj)
#pragma unroll
                    for (int i = 0; i < 4; ++i) { const float gg = acc[ai][bj][m][0][i], uu = acc[ai][bj][m][1][i]; a[bj][i] = gg * uu * __builtin_amdgcn_rcpf(1.0f + __builtin_amdgcn_exp2f(-gg * LOG2E)); }
                u32x4 w; w.x = cvtpk(a[0][0], a[0][1]); w.y = cvtpk(a[0][2], a[0][3]); w.z = cvtpk(a[1][0], a[1][1]); w.w = cvtpk(a[1][2], a[1][3]);
                bf16* op_ = O + (size_t)row * FF + u.pn * 128 + wc * 32 + fq * 8;
                if (hsel < 0) *(u32x4*)op_ = w;
                else if (hsel == 0) *(u32x2*)op_ = (u32x2){w.x, w.y};
                else *(u32x2*)(op_ + 4) = (u32x2){w.z, w.w};
            }
    }
};
}

namespace att {
constexpr int A_K = 0, A_V = 24576, A_WSF = 73728, A_LUT = 75776, A_END = 92416;
constexpr int LUTW = 1025, LUTC = 512;
struct AU {
    const bf16* q; const bf16* k; const bf16* v; long rs;
    int q0, kv0, nt;
    int W, hcol, rmul;
    void* o; long ors;
    float* lse; long lrs;
    int sink4, has_sink;
    float mfix; int res;
    int wsh, of32;
};
__device__ __forceinline__ int crow(int r, int hi) { return (r & 3) + 8 * (r >> 2) + 4 * hi; }
__device__ __forceinline__ void glds16(const void* gsrc, unsigned lds_dst) { unsigned keep;
    asm volatile("s_mov_b32 %0, m0\n\ts_mov_b32 m0, %2\n\ts_nop 0\n\tglobal_load_lds_dwordx4 %1, off\n\ts_mov_b32 m0, %0" : "=&s"(keep) : "v"(gsrc), "s"(lds_dst) : "memory"); }
#define LDS_ADDR(p) ((unsigned)__builtin_amdgcn_readfirstlane((int)(unsigned)(size_t)(p)))
__device__ __forceinline__ int t5_bucket(int rel) {
    const int n = rel < 0 ? -rel : rel;
    const int v = n < 8 ? n : 8 + (n >= 15) + (n >= 27) + (n >= 50) + (n >= 91) + (n >= 166) + (n >= 305) + (n >= 559);
    return v + (rel > 0 ? 16 : 0);
}
template <int MODE>
__device__ __forceinline__ void attn_dense(const AU& u, LAS unsigned char* lds, const float* __restrict__ relpos) {
    constexpr int DV = (MODE == 1) ? 128 : 64, NDB = DV / 32, VSLOT = 64 * DV * 2, NVP = DV / 64;
    constexpr int CL = 656;
    constexpr int A_Vx = (MODE == 2) ? 49152 : A_V, A_WSFx = (MODE == 2) ? 98304 : A_WSF, A_LUTx = (MODE == 2) ? 100352 : A_LUT;
    constexpr float THR = 8.0f;
    int tid = threadIdx.x; asm volatile("" : "+v"(tid));
    const int lane = tid & 63, r32 = lane & 31, hi = lane >> 5; const int wid = __builtin_amdgcn_readfirstlane(tid >> 6);
    const bf16* ksrc = u.k + (long)(u.kv0 + lane) * u.rs + wid * 8;
    const bf16* vsrc = u.v + (long)(u.kv0 + 16 * (wid & 3) + (lane >> 2)) * u.rs + (wid >> 2) * 32 + (lane & 3) * 8;
    const long tstride = 64 * u.rs;
#define DN_DMA_K(t, slot) glds16(ksrc + (long)(t) * tstride, LDS_ADDR(lds + A_K + (slot) * 8192 + wid * 1024))
#define DN_DMA_V(t, slot) do { \
      glds16(vsrc + (long)(t) * tstride, LDS_ADDR(lds + A_Vx + (slot) * VSLOT + wid * 1024)); \
      if (DV == 128) glds16(vsrc + (long)(t) * tstride + 64, LDS_ADDR(lds + A_Vx + (slot) * VSLOT + (wid + 8) * 1024)); \
    } while (0)
    const bool res = (MODE == 2) && (u.res != 0);
    if (res) { for (int j = 0; j < u.nt; ++j) { DN_DMA_K(j, j); DN_DMA_V(j, j); } }
    else { DN_DMA_K(0, 0); DN_DMA_V(0, 0); DN_DMA_K(1, 1); DN_DMA_K(2, 2); }
    LAS float* lut = (LAS float*)(lds + A_LUTx);
    LAS float* wsf = (LAS float*)(lds + A_WSFx) + wid * 64;
    float bL = 0.f, bR = 0.f;
    if (MODE == 1) {
        for (int i = tid; i < 2 * CL + 1; i += 512) lut[i] = relpos[t5_bucket(i - CL) * 20 + u.hcol] * LOG2E;
        bL = relpos[15 * 20 + u.hcol] * LOG2E; bR = relpos[31 * 20 + u.hcol] * LOG2E;
    }
    const int gh = (MODE == 2) ? (wid >> u.wsh) : 0;
    if (MODE == 2) {
        const int ng = 8 >> u.wsh;
        for (int i = tid; i < ng * LUTW; i += 512) { const int gg = i / LUTW, rel = (i % LUTW) - LUTC; const int ar = rel < 0 ? -rel : rel;
            lut[i] = (ar > u.W) ? NEG_BIG : relpos[t5_bucket(rel * u.rmul) * 20 + u.hcol + gg] * LOG2E; }
        lut += gh * LUTW;
    }
    const int qw = (MODE == 2) ? (u.q0 + 32 * (wid & ((1 << u.wsh) - 1))) : (u.q0 + wid * 32);
    bf16x8 qr[4];
    { const bf16* qp = u.q + (long)(qw + r32) * u.rs + hi * 8 + 64 * gh;
#pragma unroll
      for (int d0 = 0; d0 < 4; ++d0) qr[d0] = *(const bf16x8*)(qp + d0 * 16); }
    const int tlo_ = (qw - u.W - u.kv0) > 0 ? ((qw - u.W - u.kv0) >> 6) : 0;
    const int ta = res ? (tlo_ < u.nt - u.res ? tlo_ : u.nt - u.res) : 0;
    const int nt = res ? u.res : u.nt;
    const int ntd = res ? 0 : u.nt;
    const int kv0w = u.kv0 + 64 * ta;
#define SBAR() __builtin_amdgcn_sched_barrier(0)
#define PIN(x) asm volatile("" : "+v"(x))
#define EX2(v) __builtin_amdgcn_exp2f(v)
#define MFMA32(a, b, c) __builtin_amdgcn_mfma_f32_32x32x16_bf16(a, b, c, 0, 0, 0)
#define DN_KLOAD2(Ks_, j) do { kf[2 * (j)] = *(const LAS bf16x8*)((Ks_) + (j) * 2048); kf[2 * (j) + 1] = *(const LAS bf16x8*)((Ks_) + (j) * 2048 + 512); } while (0)
#define DN_VFRAG(dst, Vs_, db, ks) do { \
      const s16x4 lo_ = __builtin_bit_cast(s16x4, __builtin_amdgcn_ds_read_tr16_b64_v4i16((LAS s16x4*)((Vs_) + ((db) * 4 + (ks)) * 1024))); \
      const s16x4 hh_ = __builtin_bit_cast(s16x4, __builtin_amdgcn_ds_read_tr16_b64_v4i16((LAS s16x4*)((Vs_) + ((db) * 4 + (ks)) * 1024 + 512))); \
      dst = (bf16x8){lo_[0], lo_[1], lo_[2], lo_[3], hh_[0], hh_[1], hh_[2], hh_[3]}; } while (0)
#define DN_KIND(t_) ((MODE == 1) ? ((kv0w + 64 * (t_) + 63 - qw <= -559) ? 2 : (kv0w + 64 * (t_) - qw - 31 >= 559) ? 3 : 1) : (MODE == 2) ? 1 : 0)
#define DN_BIAS(S0, S1, t_) do { const LAS float* lp_ = lut + (kv0w + 64 * (t_) - (qw + r32) + 4 * hi + ((MODE == 2) ? LUTC : CL)); \
      _Pragma("unroll") for (int r = 0; r < 16; ++r) { S0[r] += lp_[(r & 3) + 8 * (r >> 2)]; S1[r] += lp_[32 + (r & 3) + 8 * (r >> 2)]; } } while (0)
#define MX3(a, b, c) __builtin_fmaxf(__builtin_fmaxf((a), (b)), (c))
#define DN_ROWMAX(rm_, S0, S1) do { float ra_ = MX3(S0[0], S0[1], S1[0]), rb_ = MX3(S0[2], S0[3], S1[1]); ra_ = MX3(ra_, S1[2], S1[3]); \
      _Pragma("unroll") for (int r = 4; r < 16; r += 4) { ra_ = MX3(ra_, S0[r], S0[r + 1]); rb_ = MX3(rb_, S0[r + 2], S0[r + 3]); ra_ = MX3(ra_, S1[r], S1[r + 1]); rb_ = MX3(rb_, S1[r + 2], S1[r + 3]); } \
      rm_ = __builtin_fmaxf(ra_, rb_); rm_ = __builtin_fmaxf(rm_, __shfl_xor(rm_, 32)); } while (0)
#define PKW(P, B) cvtpk(P[B], P[(B) + 1])
    const int koff = hi * 1024 + r32 * 16;
    const int voff = ((lane >> 4) & 1) * 32 + (lane & 3) * 8 + (4 * hi + ((lane & 15) >> 2)) * 64;
    const float mfix = u.mfix;
    float l_run = 0.f, cb_cur = 0.f;
    f32x16 o[NDB];
#pragma unroll
    for (int db = 0; db < NDB; ++db)
#pragma unroll
        for (int r = 0; r < 16; ++r) o[db][r] = 0.f;
    f32x16 negm;
    const f32x16 zero16 = {0.f, 0.f, 0.f, 0.f, 0.f, 0.f, 0.f, 0.f, 0.f, 0.f, 0.f, 0.f, 0.f, 0.f, 0.f, 0.f};
#define CINIT ((MODE != 1) ? negm : zero16)
#pragma unroll
    for (int r = 0; r < 16; ++r) negm[r] = -mfix;
    asm volatile("" : "+v"(negm));
    bf16x8 kf[8];
    u32x4 pw0, pw1, pw2, pw3;
    f32x16 pA0, pA1, pB0, pB1;
    asm volatile("s_waitcnt vmcnt(0) lgkmcnt(0)" ::: "memory");
    __builtin_amdgcn_s_barrier();
    asm volatile("" ::: "memory");
#define DN_SETCB(t_) do { const int kind_ = DN_KIND(t_); const float cbn_ = (kind_ == 2) ? bL : (kind_ == 3) ? bR : 0.f; \
        if (MODE == 1) cb_cur = cbn_; } while (0)
    {
        const LAS unsigned char* Ks = lds + A_K + ta * 8192 + koff;
        DN_KLOAD2(Ks, 0); DN_KLOAD2(Ks, 1); DN_KLOAD2(Ks, 2); DN_KLOAD2(Ks, 3);
        DN_SETCB(0);
        pA0 = MFMA32(kf[0], qr[0], CINIT); pA1 = MFMA32(kf[1], qr[0], CINIT);
#pragma unroll
        for (int d0 = 1; d0 < 4; ++d0) { pA0 = MFMA32(kf[2 * d0], qr[d0], pA0); pA1 = MFMA32(kf[2 * d0 + 1], qr[d0], pA1); }
        if (MODE != 0 && DN_KIND(0) == 1) DN_BIAS(pA0, pA1, 0);
        { const float shf = (MODE == 1) ? (cb_cur - mfix) : 0.f;
#pragma unroll
          for (int r = 0; r < 16; ++r) { pA0[r] = EX2(pA0[r] + shf); pA1[r] = EX2(pA1[r] + shf); } }
        asm volatile("s_waitcnt lgkmcnt(0)" ::: "memory");
        if (!res) __builtin_amdgcn_s_barrier();
        asm volatile("" ::: "memory");
        if (!res) { DN_DMA_K(3, 0); DN_DMA_V(1, 1); }
        const LAS unsigned char* Ks1 = lds + A_K + (ta + 1) * 8192 + koff;
        DN_KLOAD2(Ks1, 0); DN_KLOAD2(Ks1, 1); DN_KLOAD2(Ks1, 2); DN_KLOAD2(Ks1, 3);
        if (NVP == 1) asm volatile("s_waitcnt vmcnt(2) lgkmcnt(0)" ::: "memory"); else asm volatile("s_waitcnt vmcnt(3) lgkmcnt(0)" ::: "memory");
        if (!res) __builtin_amdgcn_s_barrier();
        asm volatile("" ::: "memory");
    }
    int sl_prev = ta, sl_cur = ta + 1, sl_next = ta + 2;
    if (wid >= 4) __builtin_amdgcn_s_setprio(1);
#define PAF(k) __builtin_bit_cast(bf16x8, pw##k)
#define GAPA(VI, DB, KS, MF, A0, A1, A2, A3, W0, W1, PW) do { DN_VFRAG(vf[VI], Vs, DB, KS); SBAR(); MF; sacc += A0; sacc += A1; sacc += A2; sacc += A3; PIN(sacc); W0; W1; PIN(PW); SBAR(); } while (0)
#define GAPB4(MF, X, B, KJ) do { MF; X[B] = EX2(X[B]); X[(B) + 1] = EX2(X[(B) + 1]); X[(B) + 2] = EX2(X[(B) + 2]); X[(B) + 3] = EX2(X[(B) + 3]); PIN(X); if ((KJ) >= 0) DN_KLOAD2(Kn, (KJ) < 0 ? 0 : (KJ)); SBAR(); } while (0)
#define GAPB2(MF, X, B, AFTER) do { MF; X[B] = EX2(X[B] + shf); X[(B) + 1] = EX2(X[(B) + 1] + shf); PIN(X); AFTER; SBAR(); } while (0)
#define DN_STEP(P0, P1, C0, C1, t_) do { \
        const LAS unsigned char* Vs = lds + A_Vx + sl_prev * VSLOT + voff; \
        const LAS unsigned char* Kn = lds + A_K + sl_next * 8192 + koff; \
        DN_SETCB(t_); \
        bf16x8 vf[8]; \
        SBAR(); \
        float sacc = P0[0] + P0[1]; \
        GAPA(0, 0, 0, C0 = MFMA32(kf[0], qr[0], CINIT), P0[2], P0[3], P0[4], P0[5],     pw0[0] = PKW(P0, 0),  pw0[1] = PKW(P0, 2),  pw0); \
        GAPA(1, 1, 0, C1 = MFMA32(kf[1], qr[0], CINIT), P0[6], P0[7], P0[8], P0[9],     pw0[2] = PKW(P0, 4),  pw0[3] = PKW(P0, 6),  pw0); \
        GAPA(2, 0, 1, C0 = MFMA32(kf[2], qr[1], C0),   P0[10], P0[11], P0[12], P0[13], pw1[0] = PKW(P0, 8),  pw1[1] = PKW(P0, 10), pw1); \
        GAPA(3, 1, 1, C1 = MFMA32(kf[3], qr[1], C1),   P0[14], P0[15], P1[0], P1[1],   pw1[2] = PKW(P0, 12), pw1[3] = PKW(P0, 14), pw1); \
        GAPA(4, 0, 2, C0 = MFMA32(kf[4], qr[2], C0),   P1[2], P1[3], P1[4], P1[5],     pw2[0] = PKW(P1, 0),  pw2[1] = PKW(P1, 2),  pw2); \
        GAPA(5, 1, 2, C1 = MFMA32(kf[5], qr[2], C1),   P1[6], P1[7], P1[8], P1[9],     pw2[2] = PKW(P1, 4),  pw2[3] = PKW(P1, 6),  pw2); \
        GAPA(6, 0, 3, C0 = MFMA32(kf[6], qr[3], C0),   P1[10], P1[11], P1[12], P1[13], pw3[0] = PKW(P1, 8),  pw3[1] = PKW(P1, 10), pw3); \
        GAPA(7, 1, 3, C1 = MFMA32(kf[7], qr[3], C1),   P1[14], P1[15], 0.f, 0.f,       pw3[2] = PKW(P1, 12), pw3[3] = PKW(P1, 14), pw3); \
        l_run += sacc; \
        if (MODE != 0 && DN_KIND(t_) == 1) DN_BIAS(C0, C1, t_); \
        const float shf = cb_cur - mfix; (void)shf; \
        SBAR(); \
        if (DV == 64) { \
            GAPB4(o[0] = MFMA32(PAF(0), vf[0], o[0]), C0, 0, -1); \
            GAPB4(o[1] = MFMA32(PAF(0), vf[1], o[1]), C0, 4, -1); \
            GAPB4(o[0] = MFMA32(PAF(1), vf[2], o[0]), C0, 8, 0); \
            GAPB4(o[1] = MFMA32(PAF(1), vf[3], o[1]), C0, 12, 1); \
            GAPB4(o[0] = MFMA32(PAF(2), vf[4], o[0]), C1, 0, 2); \
            GAPB4(o[1] = MFMA32(PAF(2), vf[5], o[1]), C1, 4, 3); \
            GAPB4(o[0] = MFMA32(PAF(3), vf[6], o[0]), C1, 8, -1); \
            if ((t_) + 3 < ntd) DN_DMA_K((t_) + 3, sl_cur); \
            GAPB4(o[1] = MFMA32(PAF(3), vf[7], o[1]), C1, 12, -1); \
            if ((t_) + 1 < ntd) DN_DMA_V((t_) + 1, sl_next); \
        } else { \
            GAPB2(o[0] = MFMA32(PAF(0), vf[0], o[0]), C0, 0,  DN_VFRAG(vf[0], Vs, 2, 0)); \
            GAPB2(o[1] = MFMA32(PAF(0), vf[1], o[1]), C0, 2,  DN_VFRAG(vf[1], Vs, 3, 0)); \
            GAPB2(o[0] = MFMA32(PAF(1), vf[2], o[0]), C0, 4,  DN_VFRAG(vf[2], Vs, 2, 1)); \
            GAPB2(o[1] = MFMA32(PAF(1), vf[3], o[1]), C0, 6,  DN_VFRAG(vf[3], Vs, 3, 1)); \
            GAPB2(o[0] = MFMA32(PAF(2), vf[4], o[0]), C0, 8,  DN_VFRAG(vf[4], Vs, 2, 2)); \
            GAPB2(o[1] = MFMA32(PAF(2), vf[5], o[1]), C0, 10, DN_VFRAG(vf[5], Vs, 3, 2)); \
            GAPB2(o[0] = MFMA32(PAF(3), vf[6], o[0]), C0, 12, DN_VFRAG(vf[6], Vs, 2, 3)); \
            GAPB2(o[1] = MFMA32(PAF(3), vf[7], o[1]), C0, 14, DN_VFRAG(vf[7], Vs, 3, 3)); \
            GAPB2(o[NDB - 2] = MFMA32(PAF(0), vf[0], o[NDB - 2]), C1, 0,  (void)0); \
            GAPB2(o[NDB - 1] = MFMA32(PAF(0), vf[1], o[NDB - 1]), C1, 2,  (void)0); \
            GAPB2(o[NDB - 2] = MFMA32(PAF(1), vf[2], o[NDB - 2]), C1, 4,  DN_KLOAD2(Kn, 0)); \
            GAPB2(o[NDB - 1] = MFMA32(PAF(1), vf[3], o[NDB - 1]), C1, 6,  DN_KLOAD2(Kn, 1)); \
            GAPB2(o[NDB - 2] = MFMA32(PAF(2), vf[4], o[NDB - 2]), C1, 8,  DN_KLOAD2(Kn, 2)); \
            GAPB2(o[NDB - 1] = MFMA32(PAF(2), vf[5], o[NDB - 1]), C1, 10, DN_KLOAD2(Kn, 3)); \
            GAPB2(o[NDB - 2] = MFMA32(PAF(3), vf[6], o[NDB - 2]), C1, 12, (void)0); \
            if ((t_) + 3 < ntd) DN_DMA_K((t_) + 3, sl_cur); \
            GAPB2(o[NDB - 1] = MFMA32(PAF(3), vf[7], o[NDB - 1]), C1, 14, (void)0); \
            if ((t_) + 1 < ntd) DN_DMA_V((t_) + 1, sl_next); \
        } \
        { const int pend = (((t_) + 3 < ntd) ? 1 : 0) + (((t_) + 1 < ntd) ? NVP : 0); \
          if (pend >= 3) asm volatile("s_waitcnt vmcnt(3) lgkmcnt(0)" ::: "memory"); \
          else if (pend == 2) asm volatile("s_waitcnt vmcnt(2) lgkmcnt(0)" ::: "memory"); \
          else if (pend == 1) asm volatile("s_waitcnt vmcnt(1) lgkmcnt(0)" ::: "memory"); \
          else asm volatile("s_waitcnt vmcnt(0) lgkmcnt(0)" ::: "memory"); } \
        if (!res) __builtin_amdgcn_s_barrier(); \
        asm volatile("" ::: "memory"); \
        { const int tmp = sl_prev; sl_prev = sl_cur; sl_cur = sl_next; sl_next = res ? sl_next + 1 : tmp; } \
    } while (0)
    int t = 1;
    for (; t + 1 < nt; t += 2) { DN_STEP(pA0, pA1, pB0, pB1, t); DN_STEP(pB0, pB1, pA0, pA1, t + 1); }
#define DN_DRAIN(X0, X1) do { \
        const LAS unsigned char* Vs = lds + A_Vx + sl_prev * VSLOT + voff; \
        float sacc = 0.f; \
        _Pragma("unroll") for (int r = 0; r < 16; ++r) sacc += X0[r] + X1[r]; \
        l_run += sacc; \
        pw0 = (u32x4){PKW(X0, 0), PKW(X0, 2), PKW(X0, 4), PKW(X0, 6)}; pw1 = (u32x4){PKW(X0, 8), PKW(X0, 10), PKW(X0, 12), PKW(X0, 14)}; \
        pw2 = (u32x4){PKW(X1, 0), PKW(X1, 2), PKW(X1, 4), PKW(X1, 6)}; pw3 = (u32x4){PKW(X1, 8), PKW(X1, 10), PKW(X1, 12), PKW(X1, 14)}; \
        _Pragma("unroll") for (int dh = 0; dh < NDB / 2; ++dh) { \
            bf16x8 vf[8]; \
            _Pragma("unroll") for (int i = 0; i < 8; ++i) DN_VFRAG(vf[i], Vs, 2 * dh + (i & 1), i >> 1); \
            o[2 * dh] = MFMA32(PAF(0), vf[0], o[2 * dh]); o[2 * dh + 1] = MFMA32(PAF(0), vf[1], o[2 * dh + 1]); \
            o[2 * dh] = MFMA32(PAF(1), vf[2], o[2 * dh]); o[2 * dh + 1] = MFMA32(PAF(1), vf[3], o[2 * dh + 1]); \
            o[2 * dh] = MFMA32(PAF(2), vf[4], o[2 * dh]); o[2 * dh + 1] = MFMA32(PAF(2), vf[5], o[2 * dh + 1]); \
            o[2 * dh] = MFMA32(PAF(3), vf[6], o[2 * dh]); o[2 * dh + 1] = MFMA32(PAF(3), vf[7], o[2 * dh + 1]); \
        } } while (0)
    if (MODE == 2 && res && (nt & 1)) {
        __builtin_amdgcn_s_setprio(0);
        DN_DRAIN(pA0, pA1);
    } else {
        DN_STEP(pA0, pA1, pB0, pB1, t);
        __builtin_amdgcn_s_setprio(0);
        DN_DRAIN(pB0, pB1);
    }
#undef DN_DRAIN
#undef DN_STEP
#undef GAPA
#undef GAPB4
#undef GAPB2
#undef PAF
#undef DN_SETCB
#undef CINIT
#undef SBAR
#undef PIN
#undef EX2
#undef MFMA32
#undef DN_DMA_K
#undef DN_DMA_V
#undef DN_KLOAD2
#undef DN_VFRAG
#undef DN_KIND
#undef DN_BIAS
#undef MX3
#undef DN_ROWMAX
#undef PKW
    float lt = l_run + __shfl_xor(l_run, 32);
    if (MODE == 2 && u.has_sink) lt += __builtin_amdgcn_exp2f(((const LAS float*)(lds + MISC_OFF))[100 + u.sink4 + gh] - mfix);
    const float inv = 1.0f / lt;
    if (MODE == 2 && u.lse && hi == 0) u.lse[(long)(qw + r32) * u.lrs] = mfix + __builtin_amdgcn_logf(lt);
    if (hi == 0) wsf[32 + r32] = inv;
    asm volatile("s_waitcnt lgkmcnt(0)" ::: "memory");
#pragma unroll
    for (int r = 0; r < 16; ++r) {
        const int qi = crow(r, hi); const float f = wsf[32 + qi];
        { bf16* op = (bf16*)u.o + (long)(qw + qi) * u.ors + r32 + 64 * gh;
#pragma unroll
            for (int db = 0; db < NDB; ++db) op[db * 32] = (bf16)(cvtpk(o[db][r] * f, 0.f) & 0xffffu); }
    }
    asm volatile("s_waitcnt vmcnt(0) lgkmcnt(0)" ::: "memory");
    __builtin_amdgcn_s_barrier();
    asm volatile("" ::: "memory");
}
}

__device__ __forceinline__ float bias_max(const float* __restrict__ relpos, int col) {
    int ln = threadIdx.x & 31; asm volatile("" : "+v"(ln)); float bm = relpos[ln * 20 + col] * LOG2E;
#pragma unroll
    for (int o = 1; o < 32; o <<= 1) bm = fmaxf(bm, __shfl_xor(bm, o));
    return bm;
}
__device__ __forceinline__ float qk_bound(const float* __restrict__ g) {
    int ln = threadIdx.x & 63; asm volatile("" : "+v"(ln)); float vq = fabsf(g[ln]), vk = fabsf(g[64 + ln]);
#pragma unroll
    for (int o = 1; o < 64; o <<= 1) { vq = fmaxf(vq, __shfl_xor(vq, o)); vk = fmaxf(vk, __shfl_xor(vk, o)); }
    return 64.0f * vq * vk * QSCALE * 1.001f;
}
struct Args { const float* in[17]; float* out; unsigned char* ws; int ph_lo, ph_hi; };
enum { I_XP = 0, I_XS, I_CP, I_CS, I_WMOD, I_BMOD, I_NMIX, I_NFFN, I_WIN, I_WOUT, I_QKG, I_SINK, I_RELPOS, I_DLAM, I_DSUB, I_WGU, I_WDN };

template <int TYPE> __device__ __forceinline__ int srccol(int g0, int j) {
    if (TYPE == 0) return g0 + j;
    if (TYPE == 1) { const int n = j >> 4, fq = (j >> 2) & 3, i = j & 3; return (g0 & ~255) + 64 * ((g0 >> 5) & 3) + 32 * (fq & 1) + 16 * n + 8 * (fq >> 1) + 4 * ((g0 >> 7) & 1) + i; }
    if (TYPE == 3) return g0 + 8 * ((j >> 2) & 3) + 4 * (j >> 4) + (j & 3);
    const int pn = g0 >> 8, bj = (g0 >> 7) & 1, wc = (g0 >> 5) & 3, n = j >> 4, fq = (j >> 2) & 3, i = j & 3;
    return n * FF + 128 * pn + 32 * wc + 8 * fq + 4 * bj + i;
}
template <int TYPE> __device__ __forceinline__ void convert_item(const float* __restrict__ W, int N, int K, bf16* WT, int kb, int nb, LAS float* scr, int lane) {
    const int k0 = 64 * kb, g0 = 32 * nb;
    const int sc = srccol<TYPE>(g0, lane & 31);
#pragma unroll 8
    for (int i = 0; i < 32; ++i) { const int kk = 2 * i + (lane >> 5); scr[kk * 33 + (lane & 31)] = __builtin_nontemporal_load(W + (size_t)(k0 + kk) * N + sc); }
    asm volatile("s_waitcnt lgkmcnt(0)" ::: "memory");
    const int c = lane & 7;
#pragma unroll
    for (int j = 0; j < 4; ++j) { const int n = (lane >> 3) + 8 * j; const LAS float* s = scr + (8 * c) * 33 + n;
        u32x4 o; o.x = cvtpk(s[0 * 33], s[1 * 33]); o.y = cvtpk(s[2 * 33], s[3 * 33]); o.z = cvtpk(s[4 * 33], s[5 * 33]); o.w = cvtpk(s[6 * 33], s[7 * 33]);
        *(u32x4*)(WT + (size_t)(g0 + n) * K + k0 + 8 * c) = o; }
    asm volatile("s_waitcnt lgkmcnt(0)" ::: "memory");
}
__device__ __forceinline__ void sincos_pi4(double r, double& s, double& c) {
    const double r2 = r * r;
    s = r * (1.0 + r2 * (-1.0 / 6 + r2 * (1.0 / 120 + r2 * (-1.0 / 5040 + r2 * (1.0 / 362880 + r2 * (-1.0 / 39916800 + r2 * (1.0 / 6227020800.0)))))));
    c = 1.0 + r2 * (-0.5 + r2 * (1.0 / 24 + r2 * (-1.0 / 720 + r2 * (1.0 / 40320 + r2 * (-1.0 / 3628800 + r2 * (1.0 / 479001600 + r2 * (-1.0 / 87178291200.0)))))));
}

__global__ void __launch_bounds__(512, 2) mega_fwd(Args a) {
    extern __shared__ __attribute__((aligned(16))) unsigned char lds_raw[];
    LAS unsigned char* lds = (LAS unsigned char*)lds_raw;
    const int tid = threadIdx.x, lane = tid & 63, wave = __builtin_amdgcn_readfirstlane(tid >> 6);
    const int G = gridDim.x, bx = blockIdx.x, vcu = (G % 8 == 0) ? (bx % 8) * (G / 8) + bx / 8 : bx;
    const int gw = vcu * 8 + wave, NGW = G * 8;
    unsigned char* ws = a.ws;
    volatile LAS unsigned* MISC = (volatile LAS unsigned*)(lds + MISC_OFF);
    for (int i = tid; i < (LDS_BYTES - MISC_OFF) / 4; i += 512) ((LAS unsigned*)(lds + MISC_OFF))[i] = 0u;
    __syncthreads();
    { LAS float* tb = (LAS float*)(lds + MISC_OFF); LAS float* st = (LAS float*)lds;
      for (int i = tid; i < 640; i += 512) st[i] = a.in[I_RELPOS][i] * LOG2E;
      for (int j = wave; j < 4 * DEPTH; j += 8) { const float qb_ = qk_bound(a.in[I_QKG] + (j >> 2) * 512 + (j & 3) * 128); if (lane == 0) tb[64 + j] = qb_; }
      if (tid < 8 * DEPTH) tb[100 + tid] = a.in[I_SINK][tid] * LOG2E;
      __syncthreads();
      if (tid < 20) { float m_ = st[tid]; for (int b_ = 1; b_ < 32; ++b_) m_ = fmaxf(m_, st[b_ * 20 + tid]); tb[80 + tid] = m_; }
      __syncthreads(); }
    XcdBarrier bar = xcd_barrier_post((unsigned*)(ws + WS_CTL) + CW_BAR, MISC + 8);
    const int lo = a.ph_lo, hi_ = a.ph_hi;
#define IN(k) (lo <= (k) && (k) < hi_)
#define SEAM(k) do { if (IN(k) && IN((k) + 1)) xcd_barrier(bar); } while (0)

    float* mod = (float*)(ws + WS_MOD);
    float2* rope = (float2*)(ws + WS_ROPE);
    bf16* Win_t = (bf16*)(ws + WS_WIN); bf16* Wout_t = (bf16*)(ws + WS_WOUT); bf16* Wgu_t = (bf16*)(ws + WS_WGU); bf16* Wdn_t = (bf16*)(ws + WS_WDN);
    bf16* Hb = (bf16*)(ws + WS_H); bf16* QKV = (bf16*)(ws + WS_QKV); bf16* MIX = (bf16*)(ws + WS_MIX); bf16* ACT = (bf16*)(ws + WS_ACT);
    bf16* BSC = (bf16*)(ws + WS_BSC); float* BLSE = (float*)(ws + WS_BLSE); bf16* CSC = (bf16*)(ws + WS_CSC);
    float* X = a.out; bf16* XB = (bf16*)(ws + WS_XB);

    if (IN(0) && !SKIP_PRO) for (int rep = 0; rep < REP_PRO; ++rep) {
        int tid = threadIdx.x; asm volatile("" : "+v"(tid)); const int lane = tid & 63;
        const int gt = vcu * 512 + tid, NTH = G * 512;
        if (gt < 2048) {
            const float invf[16] = {1.f, 0.562341332f, 0.316227764f, 0.177827939f, 0.100000001f, 0.0562341325f, 0.0316227749f, 0.0177827943f, 0.00999999978f, 0.00562341325f, 0.00316227763f, 0.00177827943f, 0.00100000005f, 0.000562341302f, 0.000316227757f, 0.00017782794f};
            const int pos = gt >> 4, p = gt & 15;
            float fr = 1.f;
#pragma unroll
            for (int i = 0; i < 16; ++i) if (p == i) fr = invf[i];
            const float ang = (float)pos * fr;
            const double x = (double)ang; const double kq = __builtin_rint(x * 0.63661977236758134308);
            const double r = __builtin_fma(-kq, 6.123233995736766035868820147292e-17, __builtin_fma(-kq, 1.57079632679489661923, x));
            double s, c; sincos_pi4(r, s, c);
            const int qd = ((int)kq) & 3;
            const double cs = (qd == 0) ? c : (qd == 1) ? -s : (qd == 2) ? -c : s;
            const double sn = (qd == 0) ? s : (qd == 1) ? c : (qd == 2) ? -s : -c;
            rope[gt] = make_float2((float)cs, (float)sn);
        }
        { LAS float* sc = (LAS float*)lds; LAS float* red = (LAS float*)(lds + 40960);
          for (int i = tid; i < NSEQ * DM; i += 512) { const int b = i >> 11, k = i & (DM - 1); const float c = (b < 4) ? a.in[I_CP][b * DM + k] : a.in[I_CS][k]; sc[i] = c / (1.0f + __expf(-c)); }
          __syncthreads();
          const int cg = tid & 15, kg = tid >> 4;
          for (int item = bx; item < DEPTH * 192; item += G) {
              const int l = item / 192, n0 = (item % 192) * 64;
              const float* w = a.in[I_WMOD] + (size_t)l * DM * NMOD + n0 + cg * 4;
              f32x4 acc[NSEQ];
#pragma unroll
              for (int b = 0; b < NSEQ; ++b) acc[b] = (f32x4){0.f, 0.f, 0.f, 0.f};
#pragma unroll 8
              for (int i = 0; i < 64; ++i) { const int k = kg + 32 * i; const f32x4 wv = __builtin_nontemporal_load((const f32x4*)(w + (size_t)k * NMOD));
#pragma unroll
                  for (int b = 0; b < NSEQ; ++b) acc[b] = acc[b] + wv * sc[b * DM + k]; }
#pragma unroll
              for (int b = 0; b < NSEQ; ++b) *(LAS f32x4*)(red + (kg * NSEQ + b) * 64 + cg * 4) = acc[b];
              __syncthreads();
              if (tid < NSEQ * 64) { const int b = tid >> 6, n = tid & 63; float s = 0.f;
#pragma unroll 8
                  for (int k2 = 0; k2 < 32; ++k2) s += red[(k2 * NSEQ + b) * 64 + n];
                  float mv = s + a.in[I_BMOD][l * NMOD + n0 + n]; const int col = n0 + n, jj = col >> 11;
                  if (jj == 1) mv = (mv + 1.0f) * a.in[I_NMIX][l * DM + (col & (DM - 1))]; else if (jj == 4) mv = (mv + 1.0f) * a.in[I_NFFN][l * DM + (col & (DM - 1))];
                  mod[(size_t)(l * NSEQ + b) * NMOD + col] = mv; }
              __syncthreads();
          } }
            __syncthreads();
        { LAS float* scr = (LAS float*)(lds + wave * 8448);
          constexpr int I_IN = 32 * 144, I_OUT = 32 * 64, I_GU = 32 * 352, I_DN = 88 * 64, I_L = I_IN + I_OUT + I_GU + I_DN;
          for (int it = gw; it < DEPTH * I_L; it += NGW) {
              const int l = it / I_L; int r = it % I_L;
              if (r < I_IN) { convert_item<1>(a.in[I_WIN] + (size_t)l * DM * INW, INW, DM, Win_t + (size_t)l * INW * DM, r / 144, r % 144, scr, lane); continue; } r -= I_IN;
              if (r < I_OUT) { convert_item<3>(a.in[I_WOUT] + (size_t)l * DM * DM, DM, DM, Wout_t + (size_t)l * DM * DM, r / 64, r % 64, scr, lane); continue; } r -= I_OUT;
              if (r < I_GU) { convert_item<2>(a.in[I_WGU] + (size_t)l * DM * 2 * FF, 2 * FF, DM, Wgu_t + (size_t)l * 2 * FF * DM, r / 352, r % 352, scr, lane); continue; } r -= I_GU;
              convert_item<3>(a.in[I_WDN] + (size_t)l * FF * DM, DM, FF, Wdn_t + (size_t)l * DM * FF, r / 64, r % 64, scr, lane);
          } }
}
    SEAM(0);

    for (int l = 0; l < DEPTH; ++l) {
        const int p0 = 1 + 8 * l;
        const float* modl = mod + (size_t)l * NSEQ * NMOD;
#define NORM_PHASE(WHICH) do { \
            int lane = threadIdx.x & 63; asm volatile("" : "+v"(lane)); \
            const bool f32src = (l == 0 && !(WHICH)); \
            _Pragma("unroll 1") for (int r = gw; r < M; r += NGW) { \
                const int b = seq_of_row(r); \
                const float* sv = modl + (size_t)b * NMOD + ((WHICH) ? 3 : 0) * DM; const float* cv = sv + DM; \
                f32x4 v[4][2]; float ss = 0.f; \
                if (f32src) { const float* xr = ((r < MP) ? a.in[I_XP] + (size_t)r * DM : a.in[I_XS] + (size_t)(r - MP) * DM) + lane * 8; \
                    _Pragma("unroll") for (int j = 0; j < 4; ++j) { v[j][0] = *(const f32x4*)(xr + 512 * j); v[j][1] = *(const f32x4*)(xr + 512 * j + 4); } } \
                else { const bf16* xr = XB + (size_t)r * DM + lane * 8; \
                    _Pragma("unroll") for (int j = 0; j < 4; ++j) { const u32x4 w = __builtin_nontemporal_load((const u32x4*)(xr + 512 * j)); \
                        v[j][0] = (f32x4){__uint_as_float(w.x << 16), __uint_as_float(w.x & 0xffff0000u), __uint_as_float(w.y << 16), __uint_as_float(w.y & 0xffff0000u)}; \
                        v[j][1] = (f32x4){__uint_as_float(w.z << 16), __uint_as_float(w.z & 0xffff0000u), __uint_as_float(w.w << 16), __uint_as_float(w.w & 0xffff0000u)}; } } \
                _Pragma("unroll") for (int j = 0; j < 4; ++j) _Pragma("unroll") for (int h2 = 0; h2 < 2; ++h2) ss += (v[j][h2][0] * v[j][h2][0] + v[j][h2][1] * v[j][h2][1]) + (v[j][h2][2] * v[j][h2][2] + v[j][h2][3] * v[j][h2][3]); \
                const float rstd = 1.0f / sqrtf(wave_sum(ss) * (1.0f / DM) + 1e-6f); \
                bf16* orow = Hb + (size_t)r * DM + lane * 8; \
                _Pragma("unroll") for (int j = 0; j < 4; ++j) { f32x4 y[2]; \
                    _Pragma("unroll") for (int h2 = 0; h2 < 2; ++h2) { const int e = 512 * j + lane * 8 + 4 * h2; const f32x4 c4 = *(const f32x4*)(cv + e), s4 = *(const f32x4*)(sv + e); \
                        y[h2] = v[j][h2] * rstd * c4 + s4; } \
                    u32x4 w; w.x = cvtpk(y[0][0], y[0][1]); w.y = cvtpk(y[0][2], y[0][3]); w.z = cvtpk(y[1][0], y[1][1]); w.w = cvtpk(y[1][2], y[1][3]); *(u32x4*)(orow + 512 * j) = w; } \
            } } while (0)
        if (IN(p0) && !SKIP_NORM) { for (int rep = 0; rep < REP_NORM; ++rep) NORM_PHASE(0); }
        SEAM(p0);
        if (IN(p0 + 1) && !SKIP_GIN) for (int rep = 0; rep < REP_GIN; ++rep) {
            pg8::Gemm g{Hb, Win_t + (size_t)l * INW * DM, M, INW, DM}; pg8::StaticOrder S; S.init(M, INW, G, bx);
            pg8::EpiQKV E{QKV, a.in[I_QKG] + l * 512, rope};
            pg8::gemm_phase<pg8::EpiQKV>(lds, g, S, E);
        }
        SEAM(p0 + 1);
        if (IN(p0 + 2) && !SKIP_ATT) for (int rep = 0; rep < (ATT_REP_MASK ? 2 : REP_ATT); ++rep) {
            const float* relpos = a.in[I_RELPOS];
            const int NU = 4608;
#define QKB(mx) (((const LAS float*)(lds + MISC_OFF))[64 + 4 * l + (mx)])
#define BIASMAX(col) (((const LAS float*)(lds + MISC_OFF))[80 + (col)])
            for (int U = vcu; U < NU; U += G) {
                if (ATT_REP_MASK && rep == 1) { const int cls = (U < 1536) ? (((U < 256) || (U >= 512 && U < 1024)) ? 1 : 2) : (U < 2304 ? 4 : 8); if (!(ATT_REP_MASK & cls)) continue; }
                att::AU u; u.res = 0; u.mfix = 0.f; u.rs = INW; u.lse = nullptr; u.lrs = 0; u.sink4 = 0; u.has_sink = 0; u.wsh = 3; u.W = 0; u.hcol = 0; u.rmul = 1; u.of32 = 0;
                if (U < 1536) {
                    int s, hh, qb, isC;
                    if (U < 256) { isC = 1; s = 4; hh = U >> 5; qb = U & 31; }
                    else if (U < 512) { const int i = U - 256; isC = 0; s = 4; hh = i >> 5; qb = i & 31; }
                    else if (U < 1024) { const int i = U - 512; isC = 1; s = i >> 7; hh = (i >> 4) & 7; qb = i & 15; }
                    else { const int i = U - 1024; isC = 0; s = i >> 7; hh = (i >> 4) & 7; qb = i & 15; }
                    const int rb = (s < 4) ? s * TP : MP, T = (s < 4) ? TP : TS;
                    const bf16* base = QKV + (size_t)rb * INW;
                    u.q0 = qb * 256; u.kv0 = 0; u.nt = T / 64;
                    if (isC) { u.q = base + C_QC + 64 * hh; u.k = base + C_KC + 64 * hh; u.v = base + C_VC + 128 * (hh >> 1); u.hcol = 16 + (hh >> 1);
                               u.o = CSC + ((size_t)rb * 8 + hh) * 128; u.ors = 1024; u.mfix = QKB(2) + BIASMAX(16 + (hh >> 1)); att::attn_dense<1>(u, lds, relpos); }
                    else { u.q = base + C_QD + 64 * hh; u.k = base + C_KD + 64 * (hh >> 2); u.v = base + C_VD + 64 * (hh >> 2);
                           u.o = MIX + (size_t)rb * DM + 1536 + 64 * hh; u.ors = DM; u.mfix = QKB(3); att::attn_dense<0>(u, lds, relpos); }
                } else if (U < 2304) {
                    const int i = U - 1536; int s, kvh, qb;
                    if (i < 512) { s = i >> 7; kvh = (i >> 6) & 1; qb = i & 63; } else { const int i2 = i - 512; s = 4; kvh = i2 >> 7; qb = i2 & 127; }
                    const int rb = (s < 4) ? s * TP : MP, T = (s < 4) ? TP : TS;
                    const bf16* base = QKV + (size_t)rb * INW;
                    u.q = base + C_QA + 256 * kvh; u.k = base + C_KA + 64 * kvh; u.v = base + C_VA + 64 * kvh;
                    u.q0 = qb * 64; u.W = 128; u.hcol = 4 * kvh; u.rmul = 1; u.wsh = 1;
                    int k0 = u.q0 - 128, k1 = u.q0 + 192; if (k0 < 0) k0 = 0; if (k1 > T) k1 = T;
                    if (((k1 - k0) >> 6) & 1) { if (k1 + 64 <= T) k1 += 64; else k0 -= 64; }
                    u.kv0 = k0; u.nt = (k1 - k0) / 64; u.res = u.nt < 5 ? u.nt : 5;
                    u.o = MIX + (size_t)rb * DM + 256 * kvh; u.ors = DM;
                    u.sink4 = 8 * l + 4 * kvh; u.has_sink = 1;
                    u.mfix = QKB(0) + fmaxf(fmaxf(BIASMAX(4 * kvh), BIASMAX(4 * kvh + 1)), fmaxf(BIASMAX(4 * kvh + 2), BIASMAX(4 * kvh + 3)));
                    att::attn_dense<2>(u, lds, relpos);
                } else {
                    const int i = U - 2304; const int pat = i / 768, rem = i % 768, hh = rem / 96, r2 = rem % 96;
                    const int rr = (pat == 0) ? 1 : (pat == 1) ? 4 : 16;
                    int s, rho, qb;
                    if (r2 < 64) { s = r2 >> 4; const int w = r2 & 15, nb = 16 / rr; rho = w / nb; qb = w % nb; }
                    else { s = 4; const int w = r2 - 64, nb = 32 / rr; rho = w / nb; qb = w % nb; }
                    const int rb = (s < 4) ? s * TP : MP, T = (s < 4) ? TP : TS, L = T / rr;
                    const bf16* base = QKV + (size_t)(rb + rho) * INW;
                    u.q = base + C_QB + 64 * hh; u.k = base + C_KB + 64 * hh; u.v = base + C_VB + 64 * hh; u.rs = (long)rr * INW;
                    u.q0 = qb * 256; u.W = 64; u.hcol = 8 + hh; u.rmul = rr; u.wsh = 3; u.res = 3;
                    int k0 = u.q0 - 64, k1 = u.q0 + 320; if (k0 < 0) k0 = 0; if (k1 > L) k1 = L;
                    if (((k1 - k0) >> 6) & 1) { if (k1 + 64 <= L) k1 += 64; else k0 -= 64; }
                    u.kv0 = k0; u.nt = (k1 - k0) / 64;
                    u.o = BSC + ((size_t)pat * M + rb + rho) * 512 + 64 * hh; u.ors = (long)rr * 512;
                    u.lse = BLSE + ((size_t)pat * M + rb + rho) * 8 + hh; u.lrs = (long)rr * 8;
                    u.mfix = QKB(1) + BIASMAX(8 + hh);
                    att::attn_dense<2>(u, lds, relpos);
                }
            }
        }
        SEAM(p0 + 2);
        if (IN(p0 + 3) && !SKIP_CMB) for (int rep = 0; rep < REP_CMB; ++rep) {
            int lane = threadIdx.x & 63; asm volatile("" : "+v"(lane));
            const float lam_init = 0.8f - 0.6f * expf(-0.3f * (float)l);
            const float* dl = a.in[I_DLAM] + l * 256;
            const float s1 = wave_sum(dl[lane] * dl[64 + lane]), s2 = wave_sum(dl[128 + lane] * dl[192 + lane]);
            const float lam = expf(s1) - expf(s2) + lam_init;
            const float* sub = a.in[I_DSUB] + l * 128;
            const int hC = lane >> 4, dC = (lane & 15) * 8, hB = lane >> 3, dB = (lane & 7) * 8;
            const f32x4 sg0 = *(const f32x4*)(sub + dC) * (1.0f - lam_init), sg1 = *(const f32x4*)(sub + dC + 4) * (1.0f - lam_init);
            for (int r = gw; r < M; r += NGW) {
                { const bf16* p0_ = CSC + ((size_t)r * 8 + hC * 2) * 128 + dC; const u32x4 w0 = __builtin_nontemporal_load((const u32x4*)p0_), w1 = __builtin_nontemporal_load((const u32x4*)(p0_ + 128));
                  float a[8];
#pragma unroll
                  for (int j = 0; j < 4; ++j) { a[2 * j] = __uint_as_float(w0[j] << 16) - lam * __uint_as_float(w1[j] << 16); a[2 * j + 1] = __uint_as_float(w0[j] & 0xffff0000u) - lam * __uint_as_float(w1[j] & 0xffff0000u); }
                  float ss = 0.f;
#pragma unroll
                  for (int j = 0; j < 8; ++j) ss += a[j] * a[j];
                  ss += __shfl_xor(ss, 1); ss += __shfl_xor(ss, 2); ss += __shfl_xor(ss, 4); ss += __shfl_xor(ss, 8);
                  const float rstd = 1.0f / sqrtf(ss * (1.0f / 128.0f) + 1e-6f);
                  u32x4 w; w.x = cvtpk(a[0] * rstd * sg0[0], a[1] * rstd * sg0[1]); w.y = cvtpk(a[2] * rstd * sg0[2], a[3] * rstd * sg0[3]);
                  w.z = cvtpk(a[4] * rstd * sg1[0], a[5] * rstd * sg1[1]); w.w = cvtpk(a[6] * rstd * sg1[2], a[7] * rstd * sg1[3]);
                  *(u32x4*)(MIX + (size_t)r * DM + 1024 + hC * 128 + dC) = w; }
                { const float e0 = BLSE[((size_t)0 * M + r) * 8 + hB], e1 = BLSE[((size_t)1 * M + r) * 8 + hB], e2 = BLSE[((size_t)2 * M + r) * 8 + hB];
                  const float mx = fmaxf(e0, fmaxf(e1, e2));
                  float w0 = __builtin_amdgcn_exp2f(e0 - mx), w1 = __builtin_amdgcn_exp2f(e1 - mx), w2 = __builtin_amdgcn_exp2f(e2 - mx);
                  const float iw = 1.0f / (w0 + w1 + w2); w0 *= iw; w1 *= iw; w2 *= iw;
                  const u32x4 q0_ = __builtin_nontemporal_load((const u32x4*)(BSC + ((size_t)0 * M + r) * 512 + hB * 64 + dB)), q1_ = __builtin_nontemporal_load((const u32x4*)(BSC + ((size_t)1 * M + r) * 512 + hB * 64 + dB)), q2_ = __builtin_nontemporal_load((const u32x4*)(BSC + ((size_t)2 * M + r) * 512 + hB * 64 + dB));
                  u32x4 w;
#pragma unroll
                  for (int j = 0; j < 4; ++j) {
                      const float lo = __uint_as_float(q0_[j] << 16) * w0 + __uint_as_float(q1_[j] << 16) * w1 + __uint_as_float(q2_[j] << 16) * w2;
                      const float hi2 = __uint_as_float(q0_[j] & 0xffff0000u) * w0 + __uint_as_float(q1_[j] & 0xffff0000u) * w1 + __uint_as_float(q2_[j] & 0xffff0000u) * w2;
                      w[j] = cvtpk(lo, hi2); }
                  *(u32x4*)(MIX + (size_t)r * DM + 512 + hB * 64 + dB) = w; }
            }
        }
        SEAM(p0 + 3);
        if (IN(p0 + 4) && !SKIP_GOUT) for (int rep = 0; rep < REP_GRES; ++rep) {
            pg8::Gemm g{MIX, Wout_t + (size_t)l * DM * DM, M, DM, DM}; pg8::StaticOrder S; S.init(M, DM, G, bx);
            const int s32 = (l == 0 && rep == 0) ? 1 : 0;
            pg8::EpiResid E{XB, s32 ? (const void*)a.in[I_XP] : (const void*)XB, s32 ? (const void*)a.in[I_XS] : (const void*)(XB + (size_t)MP * DM), modl + 2 * DM, rep == 0 ? 1.0f : 0.0f, s32, 0, 0};
            pg8::gemm_phase<pg8::EpiResid>(lds, g, S, E);
        }
        SEAM(p0 + 4);
        if (IN(p0 + 5) && !SKIP_NORM) { for (int rep = 0; rep < REP_NORM; ++rep) NORM_PHASE(1); }
        SEAM(p0 + 5);
        if (IN(p0 + 6) && !SKIP_GGU) for (int rep = 0; rep < REP_GGU; ++rep) {
            pg8::Gemm g{Hb, Wgu_t + (size_t)l * 2 * FF * DM, M, 2 * FF, DM}; pg8::StaticOrder S; S.init(M, 2 * FF, G, bx);
            const int nfull = S.nwg / G, rem_ = S.nwg % G;
            if (2 * rem_ == G) {
                S.lim = nfull * G;
                pg8::EpiSwiglu E{ACT, -1, 0};
                pg8::gemm_phase<pg8::EpiSwiglu>(lds, g, S, E);
                pg8::StaticOrder S2; S2.init(M, 2 * FF, 1 << 28, nfull * G + (bx >> 1));
                pg8::EpiSwiglu E2{ACT, bx & 1, 0};
                if (bx & 1) pg8::gemm_phase<pg8::EpiSwiglu, 1>(lds, g, S2, E2); else pg8::gemm_phase<pg8::EpiSwiglu, 0>(lds, g, S2, E2);
            } else {
                pg8::EpiSwiglu E{ACT, -1, 0};
                pg8::gemm_phase<pg8::EpiSwiglu>(lds, g, S, E);
            }
        }
        SEAM(p0 + 6);
        if (IN(p0 + 7) && !SKIP_GDN) for (int rep = 0; rep < REP_GRES; ++rep) {
            pg8::Gemm g{ACT, Wdn_t + (size_t)l * DM * FF, M, DM, FF}; pg8::StaticOrder S; S.init(M, DM, G, bx);
            const int d32 = (l + 1 == DEPTH) ? 1 : 0;
            pg8::EpiResid E{d32 ? (void*)X : (void*)XB, XB, XB + (size_t)MP * DM, modl + 5 * DM, rep == 0 ? 1.0f : 0.0f, 0, d32, 0};
            pg8::gemm_phase<pg8::EpiResid>(lds, g, S, E);
        }
        SEAM(p0 + 7);
    }
#undef IN
#undef SEAM
#undef NORM_PHASE
}

extern "C" void kernel_launch(void* const* d_in, const int* in_sizes, int n_in, void* d_out, int out_size, void* d_ws, size_t ws_size, hipStream_t stream) {
    static int grid = 0;
    if (grid == 0) {
        if (n_in != 17 || out_size != M * DM || ws_size < WS_END) { fprintf(stderr, "kernel_launch: unexpected shapes (n_in %d out %d ws %zu)\n", n_in, out_size, ws_size); grid = -1; return; }
        int dev = 0, cus = 0, per_cu = 0;
        if (hipGetDevice(&dev) != hipSuccess || hipDeviceGetAttribute(&cus, hipDeviceAttributeMultiprocessorCount, dev) != hipSuccess) { grid = -1; return; }
        if (hipFuncSetAttribute((const void*)mega_fwd, hipFuncAttributeMaxDynamicSharedMemorySize, LDS_BYTES) != hipSuccess) { fprintf(stderr, "kernel_launch: hipFuncSetAttribute failed\n"); grid = -1; return; }
        if (hipOccupancyMaxActiveBlocksPerMultiprocessor(&per_cu, (const void*)mega_fwd, 512, LDS_BYTES) != hipSuccess || per_cu < 1) { fprintf(stderr, "kernel_launch: occupancy query says %d\n", per_cu); }
        (void)hipGetLastError();
        grid = cus;
    }
    if (grid < 0) return;
    (void)hipMemsetAsync((char*)d_ws + WS_CTL, 0, CTL_ZERO_BYTES, stream);
    Args a{};
    for (int i = 0; i < 17; ++i) a.in[i] = (const float*)d_in[i];
    a.out = (float*)d_out; a.ws = (unsigned char*)d_ws;
    const int NPH = 1 + 8 * DEPTH;
#if MK_PER_PHASE
    for (int p = 0; p < NPH; ++p) { a.ph_lo = p; a.ph_hi = p + 1; hipLaunchKernelGGL(mega_fwd, dim3(grid), dim3(512), LDS_BYTES, stream, a); }
#else
    a.ph_lo = 0; a.ph_hi = NPH;
    hipLaunchKernelGGL(mega_fwd, dim3(grid), dim3(512), LDS_BYTES, stream, a);
#endif
}
```

```cpp
#include <hip/hip_runtime.h>
#include <cstdio>
#include <cstdint>

#ifndef MK_PER_PHASE
#define MK_PER_PHASE 0
#endif


#ifndef SKIP_PRO
#define SKIP_PRO 0
#endif
#ifndef SKIP_NORM
#define SKIP_NORM 0
#endif
#ifndef SKIP_GIN
#define SKIP_GIN 0
#endif
#ifndef SKIP_ATT
#define SKIP_ATT 0
#endif
#ifndef SKIP_CMB
#define SKIP_CMB 0
#endif
#ifndef SKIP_GOUT
#define SKIP_GOUT 0
#endif
#ifndef SKIP_GGU
#define SKIP_GGU 0
#endif
#ifndef SKIP_GDN
#define SKIP_GDN 0
#endif

#ifndef REP_NORM
#define REP_NORM 1
#endif
#ifndef REP_GIN
#define REP_GIN 1
#endif
#ifndef REP_ATT
#define REP_ATT 1
#endif
#ifndef REP_CMB
#define REP_CMB 1
#endif
#ifndef REP_GRES
#define REP_GRES 1
#endif
#ifndef REP_PRO
#define REP_PRO 1
#endif
#ifndef ATT_REP_MASK
#define ATT_REP_MASK 0
#endif
#ifndef REP_GGU
#define REP_GGU 1
#endif
#define GAS __attribute__((address_space(1)))
#define LAS __attribute__((address_space(3)))
typedef unsigned short bf16;
typedef short bf16x8 __attribute__((ext_vector_type(8)));
typedef short s16x4 __attribute__((ext_vector_type(4)));
typedef float f32x2 __attribute__((ext_vector_type(2)));
typedef float f32x4 __attribute__((ext_vector_type(4)));
typedef float f32x16 __attribute__((ext_vector_type(16)));
typedef unsigned u32x2 __attribute__((ext_vector_type(2)));
typedef unsigned u32x4 __attribute__((ext_vector_type(4)));
typedef __bf16 bf16x2_t __attribute__((ext_vector_type(2)));

constexpr int DM = 2048, TP = 4096, TS = 8192, MP = 16384, M = 24576, DEPTH = 4, NSEQ = 5;
constexpr int INW = 4608, FF = 5632, NMOD = 12288;
constexpr int C_QA = 0, C_KA = 512, C_VA = 640, C_QB = 768, C_KB = 1280, C_VB = 1792, C_QC = 2304, C_KC = 2816, C_VC = 3328, C_QD = 3840, C_KD = 4352, C_VD = 4480;
constexpr float LOG2E = 1.4426950408889634f;
constexpr float QSCALE = 0.125f * LOG2E;
constexpr float NEG_BIG = -1e30f, M_INIT = -30000.f;

constexpr size_t MiB = 1u << 20;
constexpr size_t WS_CTL = 0, CTL_ZERO_BYTES = 64 * 1024;
constexpr size_t WS_MOD = 1 * MiB;
constexpr size_t WS_ROPE = 2 * MiB;
constexpr size_t WS_WIN = 4 * MiB;
constexpr size_t WS_WOUT = 76 * MiB;
constexpr size_t WS_WGU = 108 * MiB;
constexpr size_t WS_WDN = 284 * MiB;
constexpr size_t WS_H = 372 * MiB;
constexpr size_t WS_QKV = 468 * MiB;
constexpr size_t WS_MIX = 684 * MiB;
constexpr size_t WS_BSC = 780 * MiB;
constexpr size_t WS_BLSE = 852 * MiB;
constexpr size_t WS_CSC = 855 * MiB;
constexpr size_t WS_XB = 903 * MiB;
constexpr size_t WS_ACT = 999 * MiB;
constexpr size_t WS_END = 1263 * MiB;
constexpr int CW_BAR = 1024;

constexpr int RING_BYTES = 131072;
constexpr int MISC_OFF = RING_BYTES;
constexpr int LDS_BYTES = 147456;

__device__ __forceinline__ unsigned cvtpk(float lo, float hi) { f32x2 v = {lo, hi}; bf16x2_t b = __builtin_convertvector(v, bf16x2_t); return __builtin_bit_cast(unsigned, b); }
__device__ __forceinline__ float wave_sum(float v) {
#pragma unroll
    for (int o = 1; o < 64; o <<= 1) v += __shfl_xor(v, o);
    return v;
}
__device__ __forceinline__ int seq_of_row(int r) { return r < MP ? (r >> 12) : 4; }
__device__ __forceinline__ int pos_of_row(int r) { return r < MP ? (r & (TP - 1)) : (r - MP); }

#define XB_TMO      128
#define XB_XCNT(j)  (256  + 64 * (j))
#define XB_XSUB(j)  (1280 + 64 * (j))
#define XB_XGEN(j)  (2304 + 64 * (j))
#define XB_TOP      3328
#define XB_TOPGEN   3392
#define XCD_BAR_WORDS 3456
#define XB_SPIN_CAP (1u << 18)
__device__ __forceinline__ unsigned xb_ld(unsigned* p)              { return __hip_atomic_load(p, __ATOMIC_RELAXED, __HIP_MEMORY_SCOPE_AGENT); }
__device__ __forceinline__ unsigned xb_add(unsigned* p, unsigned v) { return __hip_atomic_fetch_add(p, v, __ATOMIC_RELAXED, __HIP_MEMORY_SCOPE_AGENT); }
__device__ __forceinline__ unsigned xb_xcc_id() { return (unsigned)__builtin_amdgcn_s_getreg((3 << 11) | 20) & 0xFu; }
#define XB_SPIN(cond, bar) do { unsigned _sp = 0; while (cond) { __builtin_amdgcn_s_sleep(1); \
    if ((++_sp & 255u) == 0u) { if (xb_ld(&(bar)[XB_TMO])) break; if (_sp > XB_SPIN_CAP) { atomicAdd(&(bar)[XB_TMO], 1u); break; } } } } while (0)
struct XcdBarrier { unsigned* bar; unsigned x; volatile LAS unsigned* st; };
__device__ __forceinline__ XcdBarrier xcd_barrier_post(unsigned* bar, volatile LAS unsigned* st) {
    XcdBarrier b; b.bar = bar; b.x = xb_xcc_id(); b.st = st;
    if (threadIdx.x == 0) (void)xb_add(&bar[XB_XCNT(b.x)], 1u);
    return b;
}
__device__ __forceinline__ void xcd_barrier_complete(unsigned* bar, unsigned x, unsigned& nloc, unsigned& nx) {
    const unsigned G = gridDim.x * gridDim.y * gridDim.z;
    unsigned sum, cnt, mine, sp = 0u;
    for (;;) {
        sum = 0u; cnt = 0u; mine = 0u;
#pragma unroll
        for (unsigned j = 0; j < 16; ++j) { const unsigned c = xb_ld(&bar[XB_XCNT(j)]); sum += c; cnt += (c > 0u) ? 1u : 0u; mine = (j == x) ? c : mine; }
        if (sum == G) break;
        __builtin_amdgcn_s_sleep(1);
        if ((++sp & 255u) == 0u) { if (xb_ld(&bar[XB_TMO])) break; if (sp > XB_SPIN_CAP) { atomicAdd(&bar[XB_TMO], 1u); break; } }
    }
    nloc = mine > 0u ? mine : 1u; nx = cnt > 0u ? cnt : 1u;
}
__device__ __forceinline__ void xcd_barrier(const XcdBarrier& b) {
    asm volatile("s_waitcnt vmcnt(0)" ::: "memory");
    __syncthreads();
    if (threadIdx.x == 0) {
        unsigned* bar = b.bar;
        __builtin_amdgcn_s_waitcnt(0);
        unsigned nloc = b.st[0], nx = b.st[1];
        if (nloc == 0u) { xcd_barrier_complete(bar, b.x, nloc, nx); b.st[0] = nloc; b.st[1] = nx; }
        const unsigned old = xb_add(&bar[XB_XSUB(b.x)], 1u);
        const unsigned gen = old / nloc;
        if (old + 1u == (gen + 1u) * nloc) {
            __builtin_amdgcn_fence(__ATOMIC_RELEASE, "agent");
            asm volatile("s_waitcnt vmcnt(0)" ::: "memory");
            const unsigned og = xb_add(&bar[XB_TOP], 1u);
            const unsigned tg = og / nx;
            if (og + 1u == (tg + 1u) * nx) xb_add(&bar[XB_TOPGEN], 1u);
            else XB_SPIN(xb_ld(&bar[XB_TOPGEN]) == tg, bar);
            __builtin_amdgcn_fence(__ATOMIC_ACQUIRE, "agent");
            xb_add(&bar[XB_XGEN(b.x)], 1u);
            asm volatile("s_waitcnt vmcnt(0)" ::: "memory");
        } else {
            XB_SPIN(xb_ld(&bar[XB_XGEN(b.x)]) == gen, bar);
            __builtin_amdgcn_fence(__ATOMIC_ACQUIRE, "agent");
            asm volatile("s_waitcnt vmcnt(0)" ::: "memory");
        }
    }
    __syncthreads();
}

namespace pg8 {
constexpr int BM = 256, BK = 64, HALF = 128, HTB = HALF * BK * 2, STAGE_BYTES = 8 * HTB, NXCD = 8, WGM = 4;
__host__ __device__ __forceinline__ int lds_byte(int r, int c) { const int st = (r >> 4) * 2 + (c >> 5), rr = r & 15, cc = c & 31, ob = rr * 64 + cc * 2; return st * 1024 + (ob ^ (((ob >> 9) & 1) << 5)); }
__host__ __device__ __forceinline__ void stage_rc(int b, int& R, int& C) { const int st = b / 1024, sb = b % 1024, swz = sb ^ (((sb >> 9) & 1) << 5); R = (st >> 1) * 16 + swz / 64; C = (st & 1) * 32 + (swz % 64) / 2; }
struct Unit { int pm, pn; };
struct Gemm { const bf16* A; const bf16* Bt; int M, N, K; };
struct StaticOrder {
    int nM, nN, nwg, G, c;
    __host__ __device__ void init(int M_, int N_, int G_, int c_) { nM = M_ / BM; nN = N_ / BM; nwg = nM * nN; G = G_; c = c_; }
    __host__ __device__ bool next(int i, Unit& u) const {
        const long L = (long)i * G + c; if (L >= nwg) return false;
        int wgid = (int)L; { const int q = nwg / NXCD, r = nwg % NXCD, xcd = wgid % NXCD, off = wgid / NXCD; wgid = (xcd < r ? xcd * (q + 1) : r * (q + 1) + (xcd - r) * q) + off; }
        const int nig = WGM * nN, gid = wgid / nig, fm = gid * WGM, gsz = (nM - fm) < WGM ? (nM - fm) : WGM;
        u.pm = fm + ((wgid % nig) % gsz); u.pn = (wgid % nig) / gsz; return true;
    }
};
template <class Epi>
__device__ __forceinline__ void gemm_phase(LAS unsigned char* lds, const Gemm g, const StaticOrder& S, const Epi& E) {
    int tid = threadIdx.x; asm volatile("" : "+v"(tid));
    const int wid = __builtin_amdgcn_readfirstlane(tid >> 6), lane = tid & 63, wr = wid >> 2, wc = wid & 3, fr = lane & 15, fq = lane >> 4;
    const int K = g.K, nt = K / BK;
    unsigned voffA[2];
#pragma unroll
    for (int i = 0; i < 2; ++i) { int R, C; stage_rc(tid * 16 + i * 8192, R, C); voffA[i] = (unsigned)(R * K + C) * 2u; }
    const size_t kstep = (size_t)(BK * 2);
    const size_t hstep = (size_t)HALF * K * 2;
    const size_t tstep = 2 * hstep;
    const unsigned ldsw = (unsigned)wid * 1024u;
    const int aoff = lds_byte(wr * 64 + fr, fq * 8), boff = lds_byte(wc * 32 + fr, fq * 8);
#define PG8_SA(b, h) (((b) * 2 + (h)) * HTB)
#define PG8_SB(b, h) ((4 + (b) * 2 + (h)) * HTB)
#define PG8_STAGE(bufoff, gbase) do { _Pragma("unroll") for (int _i = 0; _i < 2; ++_i) \
        __builtin_amdgcn_global_load_lds((const unsigned*)((const char*)(gbase) + voffA[_i]), (LAS unsigned*)(lds + (bufoff) + ldsw + _i * 8192), 16, 0, 0); } while (0)
#define PG8_LDA(dst, b, h) do { _Pragma("unroll") for (int m = 0; m < 4; ++m) _Pragma("unroll") for (int k = 0; k < 2; ++k) dst[m][k] = *(const LAS bf16x8*)(lds + PG8_SA(b, h) + aoff + m * 2048 + k * 1024); } while (0)
#define PG8_LDB(dst, b, h) do { _Pragma("unroll") for (int n = 0; n < 2; ++n) _Pragma("unroll") for (int k = 0; k < 2; ++k) dst[n][k] = *(const LAS bf16x8*)(lds + PG8_SB(b, h) + boff + n * 2048 + k * 1024); } while (0)
#define PG8_MMA(ai, bj, At, Bt) do { __builtin_amdgcn_s_setprio(1); _Pragma("unroll") for (int m = 0; m < 4; ++m) _Pragma("unroll") for (int n = 0; n < 2; ++n) _Pragma("unroll") for (int k = 0; k < 2; ++k) \
        acc[ai][bj][m][n] = __builtin_amdgcn_mfma_f32_16x16x32_bf16(Bt[n][k], At[m][k], acc[ai][bj][m][n], 0, 0, 0); __builtin_amdgcn_s_setprio(0); } while (0)
#define PG8_WAIT_V(n) asm volatile("s_waitcnt vmcnt(" #n ")" ::: "memory")
#define PG8_WAIT_L(n) asm volatile("s_waitcnt lgkmcnt(" #n ")" ::: "memory")
#define PG8_BAR __builtin_amdgcn_s_barrier()
#define PG8_SCHED __builtin_amdgcn_sched_barrier(0)
    Unit cur, nxt; int ui = 0;
    if (!S.next(0, cur)) return;
    f32x4 acc[2][2][4][2];
#pragma unroll
    for (int a = 0; a < 2; ++a)
#pragma unroll
        for (int b = 0; b < 2; ++b)
#pragma unroll
            for (int m = 0; m < 4; ++m)
#pragma unroll
                for (int n = 0; n < 2; ++n) acc[a][b][m][n] = (f32x4){0.f, 0.f, 0.f, 0.f};
    bf16x8 At[4][2], B0[2][2], B1[2][2];
    const char* cA = (const char*)g.A + (size_t)cur.pm * tstep; const char* cB = (const char*)g.Bt + (size_t)cur.pn * tstep;
    PG8_STAGE(PG8_SB(0, 0), cB); PG8_STAGE(PG8_SB(0, 1), cB + hstep); PG8_STAGE(PG8_SA(0, 0), cA); PG8_STAGE(PG8_SA(0, 1), cA + hstep);
    if (wr == 1) PG8_BAR;
    PG8_WAIT_V(2); PG8_BAR;
    PG8_STAGE(PG8_SB(1, 0), cB + kstep); PG8_STAGE(PG8_SA(1, 0), cA + kstep); PG8_STAGE(PG8_SB(1, 1), cB + hstep + kstep);
    PG8_WAIT_V(6); PG8_BAR;
    for (;;) {
        const bool has_next = S.next(ui + 1, nxt);
        const char* nA = has_next ? (const char*)g.A + (size_t)nxt.pm * tstep : cA; const char* nB = has_next ? (const char*)g.Bt + (size_t)nxt.pn * tstep : cB;
        for (int t = 0; t < nt; t += 2) {
            const bool last = (t == nt - 2);
            const char* a1 = cA + (size_t)(t + 1) * kstep;
            const char* a2 = last ? nA : cA + (size_t)(t + 2) * kstep; const char* b2 = last ? nB : cB + (size_t)(t + 2) * kstep;
            const char* a3 = a2 + kstep; const char* b3 = b2 + kstep;
            PG8_LDB(B0, 0, 0); PG8_LDB(B1, 0, 1); PG8_SCHED; PG8_LDA(At, 0, 0); PG8_STAGE(PG8_SA(1, 1), a1 + hstep);
            PG8_WAIT_V(8); PG8_WAIT_L(0); PG8_BAR; PG8_MMA(0, 0, At, B0); PG8_MMA(0, 1, At, B1); PG8_BAR; PG8_SCHED;
            PG8_LDA(At, 0, 1); PG8_STAGE(PG8_SB(0, 0), b2); PG8_STAGE(PG8_SB(0, 1), b2 + hstep); PG8_STAGE(PG8_SA(0, 0), a2);
            PG8_WAIT_V(8); PG8_WAIT_L(0); PG8_BAR; PG8_MMA(1, 0, At, B0); PG8_MMA(1, 1, At, B1); PG8_BAR; PG8_SCHED;
            PG8_LDB(B0, 1, 0); PG8_LDB(B1, 1, 1); PG8_SCHED; PG8_LDA(At, 1, 0); PG8_STAGE(PG8_SA(0, 1), a2 + hstep);
            PG8_WAIT_V(8); PG8_WAIT_L(0); PG8_BAR; PG8_MMA(0, 0, At, B0); PG8_MMA(0, 1, At, B1); PG8_BAR; PG8_SCHED;
            PG8_LDA(At, 1, 1); PG8_STAGE(PG8_SB(1, 0), b3); PG8_STAGE(PG8_SB(1, 1), b3 + hstep); PG8_STAGE(PG8_SA(1, 0), a3);
            PG8_WAIT_V(8); PG8_WAIT_L(0); PG8_BAR; PG8_MMA(1, 0, At, B0); PG8_MMA(1, 1, At, B1); PG8_BAR; PG8_SCHED;
        }
        if (wr == 0) PG8_BAR;
        E(acc, cur, wr, wc, fr, fq);
        if (!has_next) break;
#pragma unroll
        for (int a = 0; a < 2; ++a)
#pragma unroll
            for (int b = 0; b < 2; ++b)
#pragma unroll
                for (int m = 0; m < 4; ++m)
#pragma unroll
                    for (int n = 0; n < 2; ++n) acc[a][b][m][n] = (f32x4){0.f, 0.f, 0.f, 0.f};
        cur = nxt; cA = nA; cB = nB; ++ui;
        if (wr == 1) PG8_BAR;
    }
    PG8_WAIT_V(0);
    PG8_BAR;
#undef PG8_SA
#undef PG8_SB
#undef PG8_STAGE
#undef PG8_LDA
#undef PG8_LDB
#undef PG8_MMA
#undef PG8_WAIT_V
#undef PG8_WAIT_L
#undef PG8_BAR
#undef PG8_SCHED
}

struct EpiQKV {
    bf16* O; const float* gains  ; const float2* rope  ;
    __device__ __forceinline__ void operator()(f32x4 (&acc)[2][2][4][2], const Unit& u, int wr, int wc, int fr, int fq) const {
        const int hg = u.pn * 4 + wc;
        int gi = -1; bool isq = false, rp = false;
        if (hg < 8) { gi = 0; isq = true; } else if (hg < 10) gi = 1; else if (hg < 12) gi = -1;
        else if (hg < 20) { gi = 2; isq = true; } else if (hg < 28) gi = 3; else if (hg < 36) gi = -1;
        else if (hg < 44) { gi = 4; isq = true; } else if (hg < 52) gi = 5; else if (hg < 60) gi = -1;
        else if (hg < 68) { gi = 6; isq = true; rp = true; } else if (hg < 70) { gi = 7; rp = true; }
        f32x4 gv[2][2];
#pragma unroll
        for (int bj = 0; bj < 2; ++bj)
#pragma unroll
            for (int n = 0; n < 2; ++n) { gv[bj][n] = (gi >= 0) ? *(const f32x4*)(gains + gi * 64 + 32 * (fq & 1) + 16 * n + 8 * (fq >> 1) + 4 * bj) : (f32x4){1.f, 1.f, 1.f, 1.f}; if (isq) gv[bj][n] = gv[bj][n] * QSCALE; }
#pragma unroll
        for (int ai = 0; ai < 2; ++ai)
#pragma unroll
            for (int m = 0; m < 4; ++m) {
                const int row = u.pm * BM + ai * HALF + wr * 64 + m * 16 + fr;
                f32x4 v[2][2];
#pragma unroll
                for (int bj = 0; bj < 2; ++bj)
#pragma unroll
                    for (int n = 0; n < 2; ++n) v[bj][n] = acc[ai][bj][m][n];
                float rstd = 1.f;
                if (gi >= 0) {
                    float ss = 0.f;
#pragma unroll
                    for (int bj = 0; bj < 2; ++bj)
#pragma unroll
                        for (int n = 0; n < 2; ++n) ss += (v[bj][n][0] * v[bj][n][0] + v[bj][n][1] * v[bj][n][1]) + (v[bj][n][2] * v[bj][n][2] + v[bj][n][3] * v[bj][n][3]);
                    ss += __shfl_xor(ss, 16); ss += __shfl_xor(ss, 32);
                    rstd = __builtin_amdgcn_rsqf(ss * (1.0f / 64.0f) + 1e-6f);
                }
#pragma unroll
                for (int bj = 0; bj < 2; ++bj)
#pragma unroll
                    for (int n = 0; n < 2; ++n) v[bj][n] = v[bj][n] * (gv[bj][n] * rstd);
                if (rp) {
                    const int t = pos_of_row(row);
                    const int pos = (fq & 1) ? (t & 63) : (t >> 6);
#pragma unroll
                    for (int bj = 0; bj < 2; ++bj) {
                        const float2* rp_ = rope + pos * 16 + 8 * (fq >> 1) + 4 * bj;
                        const f32x4 cs0 = *(const f32x4*)rp_, cs1 = *(const f32x4*)(rp_ + 2);
                        const float c[4] = {cs0[0], cs0[2], cs1[0], cs1[2]}, s[4] = {cs0[1], cs0[3], cs1[1], cs1[3]};
#pragma unroll
                        for (int i = 0; i < 4; ++i) { const float x1 = v[bj][0][i], x2 = v[bj][1][i]; v[bj][0][i] = x1 * c[i] - x2 * s[i]; v[bj][1][i] = x2 * c[i] + x1 * s[i]; }
                    }
                }
                bf16* rowp = O + (size_t)row * INW + hg * 64 + 32 * (fq & 1) + 8 * (fq >> 1);
#pragma unroll
                for (int n = 0; n < 2; ++n) { u32x4 w; w.x = cvtpk(v[0][n][0], v[0][n][1]); w.y = cvtpk(v[0][n][2], v[0][n][3]); w.z = cvtpk(v[1][n][0], v[1][n][1]); w.w = cvtpk(v[1][n][2], v[1][n][3]);
                    *(u32x4*)(rowp + 16 * n) = w; }
            }
    }
};
struct EpiResid {
    void* dst; const void* srcp; const void* srcs;
    const float* gate  ; float gsc; int src_f32, dst_f32, pad_;
    __device__ __forceinline__ void operator()(f32x4 (&acc)[2][2][4][2], const Unit& u, int wr, int wc, int fr, int fq) const {
        const int b = seq_of_row(u.pm * BM);
        const int col0 = u.pn * BM + wc * 32 + fq * 8;
        const float* gvec = gate + (size_t)b * (6 * DM) + col0;
        f32x4 gv[2][2];
#pragma unroll
        for (int bj = 0; bj < 2; ++bj)
#pragma unroll
            for (int n = 0; n < 2; ++n) gv[bj][n] = *(const f32x4*)(gvec + bj * HALF + n * 4) * gsc;
#pragma unroll
        for (int am = 0; am < 4; ++am) {
            const int ai = am >> 1;
            f32x4 xv[2][2][2];
#pragma unroll
            for (int mm = 0; mm < 2; ++mm) { const int m = (am & 1) * 2 + mm; const int row = u.pm * BM + ai * HALF + wr * 64 + m * 16 + fr;
                const size_t eo = ((row < MP) ? (size_t)row : (size_t)(row - MP)) * DM + col0;
                if (src_f32) { const float* rp = (const float*)((row < MP) ? srcp : srcs) + eo;
#pragma unroll
                    for (int bj = 0; bj < 2; ++bj)
#pragma unroll
                        for (int n = 0; n < 2; ++n) xv[mm][bj][n] = *(const f32x4*)(rp + bj * HALF + n * 4); }
                else { const bf16* rp = (const bf16*)((row < MP) ? srcp : srcs) + eo;
#pragma unroll
                    for (int bj = 0; bj < 2; ++bj) { const u32x4 w = *(const u32x4*)(rp + bj * HALF);
                        xv[mm][bj][0] = (f32x4){__uint_as_float(w.x << 16), __uint_as_float(w.x & 0xffff0000u), __uint_as_float(w.y << 16), __uint_as_float(w.y & 0xffff0000u)};
                        xv[mm][bj][1] = (f32x4){__uint_as_float(w.z << 16), __uint_as_float(w.z & 0xffff0000u), __uint_as_float(w.w << 16), __uint_as_float(w.w & 0xffff0000u)}; } }
            }
#pragma unroll
            for (int mm = 0; mm < 2; ++mm) { const int m = (am & 1) * 2 + mm; const size_t eo = (size_t)(u.pm * BM + ai * HALF + wr * 64 + m * 16 + fr) * DM + col0;
#pragma unroll
                for (int bj = 0; bj < 2; ++bj) { const f32x4 x0 = xv[mm][bj][0] + gv[bj][0] * acc[ai][bj][m][0], x1 = xv[mm][bj][1] + gv[bj][1] * acc[ai][bj][m][1];
                    if (dst_f32) { *(f32x4*)((float*)dst + eo + bj * HALF) = x0; *(f32x4*)((float*)dst + eo + bj * HALF + 4) = x1; }
                    else { u32x4 w; w.x = cvtpk(x0[0], x0[1]); w.y = cvtpk(x0[2], x0[3]); w.z = cvtpk(x1[0], x1[1]); w.w = cvtpk(x1[2], x1[3]); *(u32x4*)((bf16*)dst + eo + bj * HALF) = w; } }
            }
            asm volatile("" ::: "memory");
        }
    }
};
struct EpiSwiglu {
    bf16* O;
    __device__ __forceinline__ void operator()(f32x4 (&acc)[2][2][4][2], const Unit& u, int wr, int wc, int fr, int fq) const {
#pragma unroll
        for (int ai = 0; ai < 2; ++ai)
#pragma unroll
            for (int m = 0; m < 4; ++m) {
                const int row = u.pm * BM + ai * HALF + wr * 64 + m * 16 + fr;
                float a[2][4];
#pragma unroll
                for (int bj = 0; bj < 2; ++bj)
#pragma unroll
                    for (int i = 0; i < 4; ++i) { const float gg = acc[ai][bj][m][0][i], uu = acc[ai][bj][m][1][i]; a[bj][i] = gg * uu * __builtin_amdgcn_rcpf(1.0f + __builtin_amdgcn_exp2f(-gg * LOG2E)); }
                u32x4 w; w.x = cvtpk(a[0][0], a[0][1]); w.y = cvtpk(a[0][2], a[0][3]); w.z = cvtpk(a[1][0], a[1][1]); w.w = cvtpk(a[1][2], a[1][3]);
                *(u32x4*)(O + (size_t)row * FF + u.pn * 128 + wc * 32 + fq * 8) = w;
            }
    }
};
}

namespace att {
constexpr int A_K = 0, A_V = 24576, A_WSF = 73728, A_LUT = 75776, A_END = 92416;
constexpr int LUTW = 1025, LUTC = 512;
struct AU {
    const bf16* q; const bf16* k; const bf16* v; long rs;
    int q0, kv0, nt;
    int W, hcol, rmul;
    void* o; long ors;
    float* lse; long lrs;
    int sink4, has_sink;
    float mfix; int res;
    int wsh, of32;
};
__device__ __forceinline__ int crow(int r, int hi) { return (r & 3) + 8 * (r >> 2) + 4 * hi; }
__device__ __forceinline__ void glds16(const void* gsrc, unsigned lds_dst) { unsigned keep;
    asm volatile("s_mov_b32 %0, m0\n\ts_mov_b32 m0, %2\n\ts_nop 0\n\tglobal_load_lds_dwordx4 %1, off\n\ts_mov_b32 m0, %0" : "=&s"(keep) : "v"(gsrc), "s"(lds_dst) : "memory"); }
#define LDS_ADDR(p) ((unsigned)__builtin_amdgcn_readfirstlane((int)(unsigned)(size_t)(p)))
__device__ __forceinline__ int t5_bucket(int rel) {
    const int n = rel < 0 ? -rel : rel;
    const int v = n < 8 ? n : 8 + (n >= 15) + (n >= 27) + (n >= 50) + (n >= 91) + (n >= 166) + (n >= 305) + (n >= 559);
    return v + (rel > 0 ? 16 : 0);
}
template <int MODE>
__device__ __forceinline__ void attn_dense(const AU& u, LAS unsigned char* lds, const float* __restrict__ relpos) {
    constexpr int DV = (MODE == 1) ? 128 : 64, NDB = DV / 32, VSLOT = 64 * DV * 2, NVP = DV / 64;
    constexpr int CL = 656;
    constexpr int A_Vx = (MODE == 2) ? 49152 : A_V, A_WSFx = (MODE == 2) ? 98304 : A_WSF, A_LUTx = (MODE == 2) ? 100352 : A_LUT;
    constexpr float THR = 8.0f;
    int tid = threadIdx.x; asm volatile("" : "+v"(tid));
    const int lane = tid & 63, r32 = lane & 31, hi = lane >> 5; const int wid = __builtin_amdgcn_readfirstlane(tid >> 6);
    const bf16* ksrc = u.k + (long)(u.kv0 + lane) * u.rs + wid * 8;
    const bf16* vsrc = u.v + (long)(u.kv0 + 16 * (wid & 3) + (lane >> 2)) * u.rs + (wid >> 2) * 32 + (lane & 3) * 8;
    const long tstride = 64 * u.rs;
#define DN_DMA_K(t, slot) glds16(ksrc + (long)(t) * tstride, LDS_ADDR(lds + A_K + (slot) * 8192 + wid * 1024))
#define DN_DMA_V(t, slot) do { \
      glds16(vsrc + (long)(t) * tstride, LDS_ADDR(lds + A_Vx + (slot) * VSLOT + wid * 1024)); \
      if (DV == 128) glds16(vsrc + (long)(t) * tstride + 64, LDS_ADDR(lds + A_Vx + (slot) * VSLOT + (wid + 8) * 1024)); \
    } while (0)
    const bool res = (MODE == 2) && (u.res != 0);
    if (res) { for (int j = 0; j < u.nt; ++j) { DN_DMA_K(j, j); DN_DMA_V(j, j); } }
    else { DN_DMA_K(0, 0); DN_DMA_V(0, 0); DN_DMA_K(1, 1); DN_DMA_K(2, 2); }
    LAS float* lut = (LAS float*)(lds + A_LUTx);
    LAS float* wsf = (LAS float*)(lds + A_WSFx) + wid * 64;
    float bL = 0.f, bR = 0.f;
    if (MODE == 1) {
        for (int i = tid; i < 2 * CL + 1; i += 512) lut[i] = relpos[t5_bucket(i - CL) * 20 + u.hcol] * LOG2E;
        bL = relpos[15 * 20 + u.hcol] * LOG2E; bR = relpos[31 * 20 + u.hcol] * LOG2E;
    }
    const int gh = (MODE == 2) ? (wid >> u.wsh) : 0;
    if (MODE == 2) {
        const int ng = 8 >> u.wsh;
        for (int i = tid; i < ng * LUTW; i += 512) { const int gg = i / LUTW, rel = (i % LUTW) - LUTC; const int ar = rel < 0 ? -rel : rel;
            lut[i] = (ar > u.W) ? NEG_BIG : relpos[t5_bucket(rel * u.rmul) * 20 + u.hcol + gg] * LOG2E; }
        lut += gh * LUTW;
    }
    const int qw = (MODE == 2) ? (u.q0 + 32 * (wid & ((1 << u.wsh) - 1))) : (u.q0 + wid * 32);
    bf16x8 qr[4];
    { const bf16* qp = u.q + (long)(qw + r32) * u.rs + hi * 8 + 64 * gh;
#pragma unroll
      for (int d0 = 0; d0 < 4; ++d0) qr[d0] = *(const bf16x8*)(qp + d0 * 16); }
    const int tlo_ = (qw - u.W - u.kv0) > 0 ? ((qw - u.W - u.kv0) >> 6) : 0;
    const int ta = res ? (tlo_ < u.nt - u.res ? tlo_ : u.nt - u.res) : 0;
    const int nt = res ? u.res : u.nt;
    const int ntd = res ? 0 : u.nt;
    const int kv0w = u.kv0 + 64 * ta;
#define SBAR() __builtin_amdgcn_sched_barrier(0)
#define PIN(x) asm volatile("" : "+v"(x))
#define EX2(v) __builtin_amdgcn_exp2f(v)
#define MFMA32(a, b, c) __builtin_amdgcn_mfma_f32_32x32x16_bf16(a, b, c, 0, 0, 0)
#define DN_KLOAD2(Ks_, j) do { kf[2 * (j)] = *(const LAS bf16x8*)((Ks_) + (j) * 2048); kf[2 * (j) + 1] = *(const LAS bf16x8*)((Ks_) + (j) * 2048 + 512); } while (0)
#define DN_VFRAG(dst, Vs_, db, ks) do { \
      const s16x4 lo_ = __builtin_bit_cast(s16x4, __builtin_amdgcn_ds_read_tr16_b64_v4i16((LAS s16x4*)((Vs_) + ((db) * 4 + (ks)) * 1024))); \
      const s16x4 hh_ = __builtin_bit_cast(s16x4, __builtin_amdgcn_ds_read_tr16_b64_v4i16((LAS s16x4*)((Vs_) + ((db) * 4 + (ks)) * 1024 + 512))); \
      dst = (bf16x8){lo_[0], lo_[1], lo_[2], lo_[3], hh_[0], hh_[1], hh_[2], hh_[3]}; } while (0)
#define DN_KIND(t_) ((MODE == 1) ? ((kv0w + 64 * (t_) + 63 - qw <= -559) ? 2 : (kv0w + 64 * (t_) - qw - 31 >= 559) ? 3 : 1) : (MODE == 2) ? 1 : 0)
#define DN_BIAS(S0, S1, t_) do { const LAS float* lp_ = lut + (kv0w + 64 * (t_) - (qw + r32) + 4 * hi + ((MODE == 2) ? LUTC : CL)); \
      _Pragma("unroll") for (int r = 0; r < 16; ++r) { S0[r] += lp_[(r & 3) + 8 * (r >> 2)]; S1[r] += lp_[32 + (r & 3) + 8 * (r >> 2)]; } } while (0)
#define MX3(a, b, c) __builtin_fmaxf(__builtin_fmaxf((a), (b)), (c))
#define DN_ROWMAX(rm_, S0, S1) do { float ra_ = MX3(S0[0], S0[1], S1[0]), rb_ = MX3(S0[2], S0[3], S1[1]); ra_ = MX3(ra_, S1[2], S1[3]); \
      _Pragma("unroll") for (int r = 4; r < 16; r += 4) { ra_ = MX3(ra_, S0[r], S0[r + 1]); rb_ = MX3(rb_, S0[r + 2], S0[r + 3]); ra_ = MX3(ra_, S1[r], S1[r + 1]); rb_ = MX3(rb_, S1[r + 2], S1[r + 3]); } \
      rm_ = __builtin_fmaxf(ra_, rb_); rm_ = __builtin_fmaxf(rm_, __shfl_xor(rm_, 32)); } while (0)
#define PKW(P, B) cvtpk(P[B], P[(B) + 1])
    const int koff = hi * 1024 + r32 * 16;
    const int voff = ((lane >> 4) & 1) * 32 + (lane & 3) * 8 + (4 * hi + ((lane & 15) >> 2)) * 64;
    const float mfix = u.mfix;
    float l_run = 0.f, cb_cur = 0.f;
    f32x16 o[NDB];
#pragma unroll
    for (int db = 0; db < NDB; ++db)
#pragma unroll
        for (int r = 0; r < 16; ++r) o[db][r] = 0.f;
    f32x16 negm;
    const f32x16 zero16 = {0.f, 0.f, 0.f, 0.f, 0.f, 0.f, 0.f, 0.f, 0.f, 0.f, 0.f, 0.f, 0.f, 0.f, 0.f, 0.f};
#define CINIT ((MODE != 1) ? negm : zero16)
#pragma unroll
    for (int r = 0; r < 16; ++r) negm[r] = -mfix;
    asm volatile("" : "+v"(negm));
    bf16x8 kf[8];
    u32x4 pw0, pw1, pw2, pw3;
    f32x16 pA0, pA1, pB0, pB1;
    asm volatile("s_waitcnt vmcnt(0) lgkmcnt(0)" ::: "memory");
    __builtin_amdgcn_s_barrier();
    asm volatile("" ::: "memory");
#define DN_SETCB(t_) do { const int kind_ = DN_KIND(t_); const float cbn_ = (kind_ == 2) ? bL : (kind_ == 3) ? bR : 0.f; \
        if (MODE == 1) cb_cur = cbn_; } while (0)
    {
        const LAS unsigned char* Ks = lds + A_K + ta * 8192 + koff;
        DN_KLOAD2(Ks, 0); DN_KLOAD2(Ks, 1); DN_KLOAD2(Ks, 2); DN_KLOAD2(Ks, 3);
        DN_SETCB(0);
        pA0 = MFMA32(kf[0], qr[0], CINIT); pA1 = MFMA32(kf[1], qr[0], CINIT);
#pragma unroll
        for (int d0 = 1; d0 < 4; ++d0) { pA0 = MFMA32(kf[2 * d0], qr[d0], pA0); pA1 = MFMA32(kf[2 * d0 + 1], qr[d0], pA1); }
        if (MODE != 0 && DN_KIND(0) == 1) DN_BIAS(pA0, pA1, 0);
        { const float shf = (MODE == 1) ? (cb_cur - mfix) : 0.f;
#pragma unroll
          for (int r = 0; r < 16; ++r) { pA0[r] = EX2(pA0[r] + shf); pA1[r] = EX2(pA1[r] + shf); } }
        asm volatile("s_waitcnt lgkmcnt(0)" ::: "memory");
        if (!res) __builtin_amdgcn_s_barrier();
        asm volatile("" ::: "memory");
        if (!res) { DN_DMA_K(3, 0); DN_DMA_V(1, 1); }
        const LAS unsigned char* Ks1 = lds + A_K + (ta + 1) * 8192 + koff;
        DN_KLOAD2(Ks1, 0); DN_KLOAD2(Ks1, 1); DN_KLOAD2(Ks1, 2); DN_KLOAD2(Ks1, 3);
        if (NVP == 1) asm volatile("s_waitcnt vmcnt(2) lgkmcnt(0)" ::: "memory"); else asm volatile("s_waitcnt vmcnt(3) lgkmcnt(0)" ::: "memory");
        if (!res) __builtin_amdgcn_s_barrier();
        asm volatile("" ::: "memory");
    }
    int sl_prev = ta, sl_cur = ta + 1, sl_next = ta + 2;
    if (wid < 4) __builtin_amdgcn_s_setprio(1);
#define PAF(k) __builtin_bit_cast(bf16x8, pw##k)
#define GAPA(VI, DB, KS, MF, A0, A1, A2, A3, W0, W1, PW) do { DN_VFRAG(vf[VI], Vs, DB, KS); SBAR(); MF; sacc += A0; sacc += A1; sacc += A2; sacc += A3; PIN(sacc); W0; W1; PIN(PW); SBAR(); } while (0)
#define GAPB4(MF, X, B, KJ) do { MF; X[B] = EX2(X[B]); X[(B) + 1] = EX2(X[(B) + 1]); X[(B) + 2] = EX2(X[(B) + 2]); X[(B) + 3] = EX2(X[(B) + 3]); PIN(X); if ((KJ) >= 0) DN_KLOAD2(Kn, (KJ) < 0 ? 0 : (KJ)); SBAR(); } while (0)
#define GAPB2(MF, X, B, AFTER) do { MF; X[B] = EX2(X[B] + shf); X[(B) + 1] = EX2(X[(B) + 1] + shf); PIN(X); AFTER; SBAR(); } while (0)
#define DN_STEP(P0, P1, C0, C1, t_) do { \
        const LAS unsigned char* Vs = lds + A_Vx + sl_prev * VSLOT + voff; \
        const LAS unsigned char* Kn = lds + A_K + sl_next * 8192 + koff; \
        DN_SETCB(t_); \
        bf16x8 vf[8]; \
        SBAR(); \
        float sacc = P0[0] + P0[1]; \
        GAPA(0, 0, 0, C0 = MFMA32(kf[0], qr[0], CINIT), P0[2], P0[3], P0[4], P0[5],     pw0[0] = PKW(P0, 0),  pw0[1] = PKW(P0, 2),  pw0); \
        GAPA(1, 1, 0, C1 = MFMA32(kf[1], qr[0], CINIT), P0[6], P0[7], P0[8], P0[9],     pw0[2] = PKW(P0, 4),  pw0[3] = PKW(P0, 6),  pw0); \
        GAPA(2, 0, 1, C0 = MFMA32(kf[2], qr[1], C0),   P0[10], P0[11], P0[12], P0[13], pw1[0] = PKW(P0, 8),  pw1[1] = PKW(P0, 10), pw1); \
        GAPA(3, 1, 1, C1 = MFMA32(kf[3], qr[1], C1),   P0[14], P0[15], P1[0], P1[1],   pw1[2] = PKW(P0, 12), pw1[3] = PKW(P0, 14), pw1); \
        GAPA(4, 0, 2, C0 = MFMA32(kf[4], qr[2], C0),   P1[2], P1[3], P1[4], P1[5],     pw2[0] = PKW(P1, 0),  pw2[1] = PKW(P1, 2),  pw2); \
        GAPA(5, 1, 2, C1 = MFMA32(kf[5], qr[2], C1),   P1[6], P1[7], P1[8], P1[9],     pw2[2] = PKW(P1, 4),  pw2[3] = PKW(P1, 6),  pw2); \
        GAPA(6, 0, 3, C0 = MFMA32(kf[6], qr[3], C0),   P1[10], P1[11], P1[12], P1[13], pw3[0] = PKW(P1, 8),  pw3[1] = PKW(P1, 10), pw3); \
        GAPA(7, 1, 3, C1 = MFMA32(kf[7], qr[3], C1),   P1[14], P1[15], 0.f, 0.f,       pw3[2] = PKW(P1, 12), pw3[3] = PKW(P1, 14), pw3); \
        l_run += sacc; \
        if (MODE != 0 && DN_KIND(t_) == 1) DN_BIAS(C0, C1, t_); \
        const float shf = cb_cur - mfix; (void)shf; \
        SBAR(); \
        if (DV == 64) { \
            GAPB4(o[0] = MFMA32(PAF(0), vf[0], o[0]), C0, 0, -1); \
            GAPB4(o[1] = MFMA32(PAF(0), vf[1], o[1]), C0, 4, -1); \
            GAPB4(o[0] = MFMA32(PAF(1), vf[2], o[0]), C0, 8, 0); \
            GAPB4(o[1] = MFMA32(PAF(1), vf[3], o[1]), C0, 12, 1); \
            GAPB4(o[0] = MFMA32(PAF(2), vf[4], o[0]), C1, 0, 2); \
            GAPB4(o[1] = MFMA32(PAF(2), vf[5], o[1]), C1, 4, 3); \
            GAPB4(o[0] = MFMA32(PAF(3), vf[6], o[0]), C1, 8, -1); \
            if ((t_) + 3 < ntd) DN_DMA_K((t_) + 3, sl_cur); \
            GAPB4(o[1] = MFMA32(PAF(3), vf[7], o[1]), C1, 12, -1); \
            if ((t_) + 1 < ntd) DN_DMA_V((t_) + 1, sl_next); \
        } else { \
            GAPB2(o[0] = MFMA32(PAF(0), vf[0], o[0]), C0, 0,  DN_VFRAG(vf[0], Vs, 2, 0)); \
            GAPB2(o[1] = MFMA32(PAF(0), vf[1], o[1]), C0, 2,  DN_VFRAG(vf[1], Vs, 3, 0)); \
            GAPB2(o[0] = MFMA32(PAF(1), vf[2], o[0]), C0, 4,  DN_VFRAG(vf[2], Vs, 2, 1)); \
            GAPB2(o[1] = MFMA32(PAF(1), vf[3], o[1]), C0, 6,  DN_VFRAG(vf[3], Vs, 3, 1)); \
            GAPB2(o[0] = MFMA32(PAF(2), vf[4], o[0]), C0, 8,  DN_VFRAG(vf[4], Vs, 2, 2)); \
            GAPB2(o[1] = MFMA32(PAF(2), vf[5], o[1]), C0, 10, DN_VFRAG(vf[5], Vs, 3, 2)); \
            GAPB2(o[0] = MFMA32(PAF(3), vf[6], o[0]), C0, 12, DN_VFRAG(vf[6], Vs, 2, 3)); \
            GAPB2(o[1] = MFMA32(PAF(3), vf[7], o[1]), C0, 14, DN_VFRAG(vf[7], Vs, 3, 3)); \
            GAPB2(o[NDB - 2] = MFMA32(PAF(0), vf[0], o[NDB - 2]), C1, 0,  (void)0); \
            GAPB2(o[NDB - 1] = MFMA32(PAF(0), vf[1], o[NDB - 1]), C1, 2,  (void)0); \
            GAPB2(o[NDB - 2] = MFMA32(PAF(1), vf[2], o[NDB - 2]), C1, 4,  DN_KLOAD2(Kn, 0)); \
            GAPB2(o[NDB - 1] = MFMA32(PAF(1), vf[3], o[NDB - 1]), C1, 6,  DN_KLOAD2(Kn, 1)); \
            GAPB2(o[NDB - 2] = MFMA32(PAF(2), vf[4], o[NDB - 2]), C1, 8,  DN_KLOAD2(Kn, 2)); \
            GAPB2(o[NDB - 1] = MFMA32(PAF(2), vf[5], o[NDB - 1]), C1, 10, DN_KLOAD2(Kn, 3)); \
            GAPB2(o[NDB - 2] = MFMA32(PAF(3), vf[6], o[NDB - 2]), C1, 12, (void)0); \
            if ((t_) + 3 < ntd) DN_DMA_K((t_) + 3, sl_cur); \
            GAPB2(o[NDB - 1] = MFMA32(PAF(3), vf[7], o[NDB - 1]), C1, 14, (void)0); \
            if ((t_) + 1 < ntd) DN_DMA_V((t_) + 1, sl_next); \
        } \
        { const int pend = (((t_) + 3 < ntd) ? 1 : 0) + (((t_) + 1 < ntd) ? NVP : 0); \
          if (pend >= 3) asm volatile("s_waitcnt vmcnt(3) lgkmcnt(0)" ::: "memory"); \
          else if (pend == 2) asm volatile("s_waitcnt vmcnt(2) lgkmcnt(0)" ::: "memory"); \
          else if (pend == 1) asm volatile("s_waitcnt vmcnt(1) lgkmcnt(0)" ::: "memory"); \
          else asm volatile("s_waitcnt vmcnt(0) lgkmcnt(0)" ::: "memory"); } \
        if (!res) __builtin_amdgcn_s_barrier(); \
        asm volatile("" ::: "memory"); \
        { const int tmp = sl_prev; sl_prev = sl_cur; sl_cur = sl_next; sl_next = res ? sl_next + 1 : tmp; } \
    } while (0)
    int t = 1;
    for (; t + 1 < nt; t += 2) { DN_STEP(pA0, pA1, pB0, pB1, t); DN_STEP(pB0, pB1, pA0, pA1, t + 1); }
#define DN_DRAIN(X0, X1) do { \
        const LAS unsigned char* Vs = lds + A_Vx + sl_prev * VSLOT + voff; \
        float sacc = 0.f; \
        _Pragma("unroll") for (int r = 0; r < 16; ++r) sacc += X0[r] + X1[r]; \
        l_run += sacc; \
        pw0 = (u32x4){PKW(X0, 0), PKW(X0, 2), PKW(X0, 4), PKW(X0, 6)}; pw1 = (u32x4){PKW(X0, 8), PKW(X0, 10), PKW(X0, 12), PKW(X0, 14)}; \
        pw2 = (u32x4){PKW(X1, 0), PKW(X1, 2), PKW(X1, 4), PKW(X1, 6)}; pw3 = (u32x4){PKW(X1, 8), PKW(X1, 10), PKW(X1, 12), PKW(X1, 14)}; \
        _Pragma("unroll") for (int dh = 0; dh < NDB / 2; ++dh) { \
            bf16x8 vf[8]; \
            _Pragma("unroll") for (int i = 0; i < 8; ++i) DN_VFRAG(vf[i], Vs, 2 * dh + (i & 1), i >> 1); \
            o[2 * dh] = MFMA32(PAF(0), vf[0], o[2 * dh]); o[2 * dh + 1] = MFMA32(PAF(0), vf[1], o[2 * dh + 1]); \
            o[2 * dh] = MFMA32(PAF(1), vf[2], o[2 * dh]); o[2 * dh + 1] = MFMA32(PAF(1), vf[3], o[2 * dh + 1]); \
            o[2 * dh] = MFMA32(PAF(2), vf[4], o[2 * dh]); o[2 * dh + 1] = MFMA32(PAF(2), vf[5], o[2 * dh + 1]); \
            o[2 * dh] = MFMA32(PAF(3), vf[6], o[2 * dh]); o[2 * dh + 1] = MFMA32(PAF(3), vf[7], o[2 * dh + 1]); \
        } } while (0)
    if (MODE == 2 && res && (nt & 1)) {
        __builtin_amdgcn_s_setprio(0);
        DN_DRAIN(pA0, pA1);
    } else {
        DN_STEP(pA0, pA1, pB0, pB1, t);
        __builtin_amdgcn_s_setprio(0);
        DN_DRAIN(pB0, pB1);
    }
#undef DN_DRAIN
#undef DN_STEP
#undef GAPA
#undef GAPB4
#undef GAPB2
#undef PAF
#undef DN_SETCB
#undef CINIT
#undef SBAR
#undef PIN
#undef EX2
#undef MFMA32
#undef DN_DMA_K
#undef DN_DMA_V
#undef DN_KLOAD2
#undef DN_VFRAG
#undef DN_KIND
#undef DN_BIAS
#undef MX3
#undef DN_ROWMAX
#undef PKW
    float lt = l_run + __shfl_xor(l_run, 32);
    if (MODE == 2 && u.has_sink) lt += __builtin_amdgcn_exp2f(((const LAS float*)(lds + MISC_OFF))[100 + u.sink4 + gh] - mfix);
    const float inv = 1.0f / lt;
    if (MODE == 2 && u.lse && hi == 0) u.lse[(long)(qw + r32) * u.lrs] = mfix + __builtin_amdgcn_logf(lt);
    if (hi == 0) wsf[32 + r32] = inv;
    asm volatile("s_waitcnt lgkmcnt(0)" ::: "memory");
#pragma unroll
    for (int r = 0; r < 16; ++r) {
        const int qi = crow(r, hi); const float f = wsf[32 + qi];
        { bf16* op = (bf16*)u.o + (long)(qw + qi) * u.ors + r32 + 64 * gh;
#pragma unroll
            for (int db = 0; db < NDB; ++db) op[db * 32] = (bf16)(cvtpk(o[db][r] * f, 0.f) & 0xffffu); }
    }
    asm volatile("s_waitcnt vmcnt(0) lgkmcnt(0)" ::: "memory");
    __builtin_amdgcn_s_barrier();
    asm volatile("" ::: "memory");
}
}

__device__ __forceinline__ float bias_max(const float* __restrict__ relpos, int col) {
    int ln = threadIdx.x & 31; asm volatile("" : "+v"(ln)); float bm = relpos[ln * 20 + col] * LOG2E;
#pragma unroll
    for (int o = 1; o < 32; o <<= 1) bm = fmaxf(bm, __shfl_xor(bm, o));
    return bm;
}
__device__ __forceinline__ float qk_bound(const float* __restrict__ g) {
    int ln = threadIdx.x & 63; asm volatile("" : "+v"(ln)); float vq = fabsf(g[ln]), vk = fabsf(g[64 + ln]);
#pragma unroll
    for (int o = 1; o < 64; o <<= 1) { vq = fmaxf(vq, __shfl_xor(vq, o)); vk = fmaxf(vk, __shfl_xor(vk, o)); }
    return 64.0f * vq * vk * QSCALE * 1.001f;
}
struct Args { const float* in[17]; float* out; unsigned char* ws; int ph_lo, ph_hi; };
enum { I_XP = 0, I_XS, I_CP, I_CS, I_WMOD, I_BMOD, I_NMIX, I_NFFN, I_WIN, I_WOUT, I_QKG, I_SINK, I_RELPOS, I_DLAM, I_DSUB, I_WGU, I_WDN };

template <int TYPE> __device__ __forceinline__ int srccol(int g0, int j) {
    if (TYPE == 0) return g0 + j;
    if (TYPE == 1) { const int n = j >> 4, fq = (j >> 2) & 3, i = j & 3; return (g0 & ~255) + 64 * ((g0 >> 5) & 3) + 32 * (fq & 1) + 16 * n + 8 * (fq >> 1) + 4 * ((g0 >> 7) & 1) + i; }
    if (TYPE == 3) return g0 + 8 * ((j >> 2) & 3) + 4 * (j >> 4) + (j & 3);
    const int pn = g0 >> 8, bj = (g0 >> 7) & 1, wc = (g0 >> 5) & 3, n = j >> 4, fq = (j >> 2) & 3, i = j & 3;
    return n * FF + 128 * pn + 32 * wc + 8 * fq + 4 * bj + i;
}
template <int TYPE> __device__ __forceinline__ void convert_item(const float* __restrict__ W, int N, int K, bf16* WT, int kb, int nb, LAS float* scr, int lane) {
    const int k0 = 64 * kb, g0 = 32 * nb;
    const int sc = srccol<TYPE>(g0, lane & 31);
#pragma unroll 8
    for (int i = 0; i < 32; ++i) { const int kk = 2 * i + (lane >> 5); scr[kk * 33 + (lane & 31)] = __builtin_nontemporal_load(W + (size_t)(k0 + kk) * N + sc); }
    asm volatile("s_waitcnt lgkmcnt(0)" ::: "memory");
    const int c = lane & 7;
#pragma unroll
    for (int j = 0; j < 4; ++j) { const int n = (lane >> 3) + 8 * j; const LAS float* s = scr + (8 * c) * 33 + n;
        u32x4 o; o.x = cvtpk(s[0 * 33], s[1 * 33]); o.y = cvtpk(s[2 * 33], s[3 * 33]); o.z = cvtpk(s[4 * 33], s[5 * 33]); o.w = cvtpk(s[6 * 33], s[7 * 33]);
        *(u32x4*)(WT + (size_t)(g0 + n) * K + k0 + 8 * c) = o; }
    asm volatile("s_waitcnt lgkmcnt(0)" ::: "memory");
}
__device__ __forceinline__ void sincos_pi4(double r, double& s, double& c) {
    const double r2 = r * r;
    s = r * (1.0 + r2 * (-1.0 / 6 + r2 * (1.0 / 120 + r2 * (-1.0 / 5040 + r2 * (1.0 / 362880 + r2 * (-1.0 / 39916800 + r2 * (1.0 / 6227020800.0)))))));
    c = 1.0 + r2 * (-0.5 + r2 * (1.0 / 24 + r2 * (-1.0 / 720 + r2 * (1.0 / 40320 + r2 * (-1.0 / 3628800 + r2 * (1.0 / 479001600 + r2 * (-1.0 / 87178291200.0)))))));
}

__global__ void __launch_bounds__(512, 2) mega_fwd(Args a) {
    extern __shared__ __attribute__((aligned(16))) unsigned char lds_raw[];
    LAS unsigned char* lds = (LAS unsigned char*)lds_raw;
    const int tid = threadIdx.x, lane = tid & 63, wave = __builtin_amdgcn_readfirstlane(tid >> 6);
    const int G = gridDim.x, bx = blockIdx.x, vcu = (G % 8 == 0) ? (bx % 8) * (G / 8) + bx / 8 : bx;
    const int gw = vcu * 8 + wave, NGW = G * 8;
    unsigned char* ws = a.ws;
    volatile LAS unsigned* MISC = (volatile LAS unsigned*)(lds + MISC_OFF);
    for (int i = tid; i < (LDS_BYTES - MISC_OFF) / 4; i += 512) ((LAS unsigned*)(lds + MISC_OFF))[i] = 0u;
    __syncthreads();
    { LAS float* tb = (LAS float*)(lds + MISC_OFF); LAS float* st = (LAS float*)lds;
      for (int i = tid; i < 640; i += 512) st[i] = a.in[I_RELPOS][i] * LOG2E;
      for (int j = wave; j < 4 * DEPTH; j += 8) { const float qb_ = qk_bound(a.in[I_QKG] + (j >> 2) * 512 + (j & 3) * 128); if (lane == 0) tb[64 + j] = qb_; }
      if (tid < 8 * DEPTH) tb[100 + tid] = a.in[I_SINK][tid] * LOG2E;
      __syncthreads();
      if (tid < 20) { float m_ = st[tid]; for (int b_ = 1; b_ < 32; ++b_) m_ = fmaxf(m_, st[b_ * 20 + tid]); tb[80 + tid] = m_; }
      __syncthreads(); }
    XcdBarrier bar = xcd_barrier_post((unsigned*)(ws + WS_CTL) + CW_BAR, MISC + 8);
    const int lo = a.ph_lo, hi_ = a.ph_hi;
#define IN(k) (lo <= (k) && (k) < hi_)
#define SEAM(k) do { if (IN(k) && IN((k) + 1)) xcd_barrier(bar); } while (0)

    float* mod = (float*)(ws + WS_MOD);
    float2* rope = (float2*)(ws + WS_ROPE);
    bf16* Win_t = (bf16*)(ws + WS_WIN); bf16* Wout_t = (bf16*)(ws + WS_WOUT); bf16* Wgu_t = (bf16*)(ws + WS_WGU); bf16* Wdn_t = (bf16*)(ws + WS_WDN);
    bf16* Hb = (bf16*)(ws + WS_H); bf16* QKV = (bf16*)(ws + WS_QKV); bf16* MIX = (bf16*)(ws + WS_MIX); bf16* ACT = (bf16*)(ws + WS_ACT);
    bf16* BSC = (bf16*)(ws + WS_BSC); float* BLSE = (float*)(ws + WS_BLSE); bf16* CSC = (bf16*)(ws + WS_CSC);
    float* X = a.out; bf16* XB = (bf16*)(ws + WS_XB);

    if (IN(0) && !SKIP_PRO) for (int rep = 0; rep < REP_PRO; ++rep) {
        int tid = threadIdx.x; asm volatile("" : "+v"(tid)); const int lane = tid & 63;
        const int gt = vcu * 512 + tid, NTH = G * 512;
        if (gt < 2048) {
            const float invf[16] = {1.f, 0.562341332f, 0.316227764f, 0.177827939f, 0.100000001f, 0.0562341325f, 0.0316227749f, 0.0177827943f, 0.00999999978f, 0.00562341325f, 0.00316227763f, 0.00177827943f, 0.00100000005f, 0.000562341302f, 0.000316227757f, 0.00017782794f};
            const int pos = gt >> 4, p = gt & 15;
            float fr = 1.f;
#pragma unroll
            for (int i = 0; i < 16; ++i) if (p == i) fr = invf[i];
            const float ang = (float)pos * fr;
            const double x = (double)ang; const double kq = __builtin_rint(x * 0.63661977236758134308);
            const double r = __builtin_fma(-kq, 6.123233995736766035868820147292e-17, __builtin_fma(-kq, 1.57079632679489661923, x));
            double s, c; sincos_pi4(r, s, c);
            const int qd = ((int)kq) & 3;
            const double cs = (qd == 0) ? c : (qd == 1) ? -s : (qd == 2) ? -c : s;
            const double sn = (qd == 0) ? s : (qd == 1) ? c : (qd == 2) ? -s : -c;
            rope[gt] = make_float2((float)cs, (float)sn);
        }
        { LAS float* sc = (LAS float*)lds; LAS float* red = (LAS float*)(lds + 40960);
          for (int i = tid; i < NSEQ * DM; i += 512) { const int b = i >> 11, k = i & (DM - 1); const float c = (b < 4) ? a.in[I_CP][b * DM + k] : a.in[I_CS][k]; sc[i] = c / (1.0f + __expf(-c)); }
          __syncthreads();
          const int cg = tid & 15, kg = tid >> 4;
          for (int item = bx; item < DEPTH * 192; item += G) {
              const int l = item / 192, n0 = (item % 192) * 64;
              const float* w = a.in[I_WMOD] + (size_t)l * DM * NMOD + n0 + cg * 4;
              f32x4 acc[NSEQ];
#pragma unroll
              for (int b = 0; b < NSEQ; ++b) acc[b] = (f32x4){0.f, 0.f, 0.f, 0.f};
#pragma unroll 8
              for (int i = 0; i < 64; ++i) { const int k = kg + 32 * i; const f32x4 wv = __builtin_nontemporal_load((const f32x4*)(w + (size_t)k * NMOD));
#pragma unroll
                  for (int b = 0; b < NSEQ; ++b) acc[b] = acc[b] + wv * sc[b * DM + k]; }
#pragma unroll
              for (int b = 0; b < NSEQ; ++b) *(LAS f32x4*)(red + (kg * NSEQ + b) * 64 + cg * 4) = acc[b];
              __syncthreads();
              if (tid < NSEQ * 64) { const int b = tid >> 6, n = tid & 63; float s = 0.f;
#pragma unroll 8
                  for (int k2 = 0; k2 < 32; ++k2) s += red[(k2 * NSEQ + b) * 64 + n];
                  float mv = s + a.in[I_BMOD][l * NMOD + n0 + n]; const int col = n0 + n, jj = col >> 11;
                  if (jj == 1) mv = (mv + 1.0f) * a.in[I_NMIX][l * DM + (col & (DM - 1))]; else if (jj == 4) mv = (mv + 1.0f) * a.in[I_NFFN][l * DM + (col & (DM - 1))];
                  mod[(size_t)(l * NSEQ + b) * NMOD + col] = mv; }
              __syncthreads();
          } }
            __syncthreads();
        { LAS float* scr = (LAS float*)(lds + wave * 8448);
          constexpr int I_IN = 32 * 144, I_OUT = 32 * 64, I_GU = 32 * 352, I_DN = 88 * 64, I_L = I_IN + I_OUT + I_GU + I_DN;
          for (int it = gw; it < DEPTH * I_L; it += NGW) {
              const int l = it / I_L; int r = it % I_L;
              if (r < I_IN) { convert_item<1>(a.in[I_WIN] + (size_t)l * DM * INW, INW, DM, Win_t + (size_t)l * INW * DM, r / 144, r % 144, scr, lane); continue; } r -= I_IN;
              if (r < I_OUT) { convert_item<3>(a.in[I_WOUT] + (size_t)l * DM * DM, DM, DM, Wout_t + (size_t)l * DM * DM, r / 64, r % 64, scr, lane); continue; } r -= I_OUT;
              if (r < I_GU) { convert_item<2>(a.in[I_WGU] + (size_t)l * DM * 2 * FF, 2 * FF, DM, Wgu_t + (size_t)l * 2 * FF * DM, r / 352, r % 352, scr, lane); continue; } r -= I_GU;
              convert_item<3>(a.in[I_WDN] + (size_t)l * FF * DM, DM, FF, Wdn_t + (size_t)l * DM * FF, r / 64, r % 64, scr, lane);
          } }
}
    SEAM(0);

    for (int l = 0; l < DEPTH; ++l) {
        const int p0 = 1 + 8 * l;
        const float* modl = mod + (size_t)l * NSEQ * NMOD;
#define NORM_PHASE(WHICH) do { \
            int lane = threadIdx.x & 63; asm volatile("" : "+v"(lane)); \
            const bool f32src = (l == 0 && !(WHICH)); \
            _Pragma("unroll 1") for (int r = gw; r < M; r += NGW) { \
                const int b = seq_of_row(r); \
                const float* sv = modl + (size_t)b * NMOD + ((WHICH) ? 3 : 0) * DM; const float* cv = sv + DM; \
                f32x4 v[4][2]; float ss = 0.f; \
                if (f32src) { const float* xr = ((r < MP) ? a.in[I_XP] + (size_t)r * DM : a.in[I_XS] + (size_t)(r - MP) * DM) + lane * 8; \
                    _Pragma("unroll") for (int j = 0; j < 4; ++j) { v[j][0] = *(const f32x4*)(xr + 512 * j); v[j][1] = *(const f32x4*)(xr + 512 * j + 4); } } \
                else { const bf16* xr = XB + (size_t)r * DM + lane * 8; \
                    _Pragma("unroll") for (int j = 0; j < 4; ++j) { const u32x4 w = __builtin_nontemporal_load((const u32x4*)(xr + 512 * j)); \
                        v[j][0] = (f32x4){__uint_as_float(w.x << 16), __uint_as_float(w.x & 0xffff0000u), __uint_as_float(w.y << 16), __uint_as_float(w.y & 0xffff0000u)}; \
                        v[j][1] = (f32x4){__uint_as_float(w.z << 16), __uint_as_float(w.z & 0xffff0000u), __uint_as_float(w.w << 16), __uint_as_float(w.w & 0xffff0000u)}; } } \
                _Pragma("unroll") for (int j = 0; j < 4; ++j) _Pragma("unroll") for (int h2 = 0; h2 < 2; ++h2) ss += (v[j][h2][0] * v[j][h2][0] + v[j][h2][1] * v[j][h2][1]) + (v[j][h2][2] * v[j][h2][2] + v[j][h2][3] * v[j][h2][3]); \
                const float rstd = 1.0f / sqrtf(wave_sum(ss) * (1.0f / DM) + 1e-6f); \
                bf16* orow = Hb + (size_t)r * DM + lane * 8; \
                _Pragma("unroll") for (int j = 0; j < 4; ++j) { f32x4 y[2]; \
                    _Pragma("unroll") for (int h2 = 0; h2 < 2; ++h2) { const int e = 512 * j + lane * 8 + 4 * h2; const f32x4 c4 = *(const f32x4*)(cv + e), s4 = *(const f32x4*)(sv + e); \
                        y[h2] = v[j][h2] * rstd * c4 + s4; } \
                    u32x4 w; w.x = cvtpk(y[0][0], y[0][1]); w.y = cvtpk(y[0][2], y[0][3]); w.z = cvtpk(y[1][0], y[1][1]); w.w = cvtpk(y[1][2], y[1][3]); *(u32x4*)(orow + 512 * j) = w; } \
            } } while (0)
        if (IN(p0) && !SKIP_NORM) { for (int rep = 0; rep < REP_NORM; ++rep) NORM_PHASE(0); }
        SEAM(p0);
        if (IN(p0 + 1) && !SKIP_GIN) for (int rep = 0; rep < REP_GIN; ++rep) {
            pg8::Gemm g{Hb, Win_t + (size_t)l * INW * DM, M, INW, DM}; pg8::StaticOrder S; S.init(M, INW, G, bx);
            pg8::EpiQKV E{QKV, a.in[I_QKG] + l * 512, rope};
            pg8::gemm_phase<pg8::EpiQKV>(lds, g, S, E);
        }
        SEAM(p0 + 1);
        if (IN(p0 + 2) && !SKIP_ATT) for (int rep = 0; rep < (ATT_REP_MASK ? 2 : REP_ATT); ++rep) {
            const float* relpos = a.in[I_RELPOS];
            const int NU = 4608;
#define QKB(mx) (((const LAS float*)(lds + MISC_OFF))[64 + 4 * l + (mx)])
#define BIASMAX(col) (((const LAS float*)(lds + MISC_OFF))[80 + (col)])
            for (int U = vcu; U < NU; U += G) {
                if (ATT_REP_MASK && rep == 1) { const int cls = (U < 1536) ? (((U < 256) || (U >= 512 && U < 1024)) ? 1 : 2) : (U < 2304 ? 4 : 8); if (!(ATT_REP_MASK & cls)) continue; }
                att::AU u; u.res = 0; u.mfix = 0.f; u.rs = INW; u.lse = nullptr; u.lrs = 0; u.sink4 = 0; u.has_sink = 0; u.wsh = 3; u.W = 0; u.hcol = 0; u.rmul = 1; u.of32 = 0;
                if (U < 1536) {
                    int s, hh, qb, isC;
                    if (U < 256) { isC = 1; s = 4; hh = U >> 5; qb = U & 31; }
                    else if (U < 512) { const int i = U - 256; isC = 0; s = 4; hh = i >> 5; qb = i & 31; }
                    else if (U < 1024) { const int i = U - 512; isC = 1; s = i >> 7; hh = (i >> 4) & 7; qb = i & 15; }
                    else { const int i = U - 1024; isC = 0; s = i >> 7; hh = (i >> 4) & 7; qb = i & 15; }
                    const int rb = (s < 4) ? s * TP : MP, T = (s < 4) ? TP : TS;
                    const bf16* base = QKV + (size_t)rb * INW;
                    u.q0 = qb * 256; u.kv0 = 0; u.nt = T / 64;
                    if (isC) { u.q = base + C_QC + 64 * hh; u.k = base + C_KC + 64 * hh; u.v = base + C_VC + 128 * (hh >> 1); u.hcol = 16 + (hh >> 1);
                               u.o = CSC + ((size_t)rb * 8 + hh) * 128; u.ors = 1024; u.mfix = QKB(2) + BIASMAX(16 + (hh >> 1)); att::attn_dense<1>(u, lds, relpos); }
                    else { u.q = base + C_QD + 64 * hh; u.k = base + C_KD + 64 * (hh >> 2); u.v = base + C_VD + 64 * (hh >> 2);
                           u.o = MIX + (size_t)rb * DM + 1536 + 64 * hh; u.ors = DM; u.mfix = QKB(3); att::attn_dense<0>(u, lds, relpos); }
                } else if (U < 2304) {
                    const int i = U - 1536; int s, kvh, qb;
                    if (i < 512) { s = i >> 7; kvh = (i >> 6) & 1; qb = i & 63; } else { const int i2 = i - 512; s = 4; kvh = i2 >> 7; qb = i2 & 127; }
                    const int rb = (s < 4) ? s * TP : MP, T = (s < 4) ? TP : TS;
                    const bf16* base = QKV + (size_t)rb * INW;
                    u.q = base + C_QA + 256 * kvh; u.k = base + C_KA + 64 * kvh; u.v = base + C_VA + 64 * kvh;
                    u.q0 = qb * 64; u.W = 128; u.hcol = 4 * kvh; u.rmul = 1; u.wsh = 1;
                    int k0 = u.q0 - 128, k1 = u.q0 + 192; if (k0 < 0) k0 = 0; if (k1 > T) k1 = T;
                    if (((k1 - k0) >> 6) & 1) { if (k1 + 64 <= T) k1 += 64; else k0 -= 64; }
                    u.kv0 = k0; u.nt = (k1 - k0) / 64; u.res = u.nt < 5 ? u.nt : 5;
                    u.o = MIX + (size_t)rb * DM + 256 * kvh; u.ors = DM;
                    u.sink4 = 8 * l + 4 * kvh; u.has_sink = 1;
                    u.mfix = QKB(0) + fmaxf(fmaxf(BIASMAX(4 * kvh), BIASMAX(4 * kvh + 1)), fmaxf(BIASMAX(4 * kvh + 2), BIASMAX(4 * kvh + 3)));
                    att::attn_dense<2>(u, lds, relpos);
                } else {
                    const int i = U - 2304; const int pat = i / 768, rem = i % 768, hh = rem / 96, r2 = rem % 96;
                    const int rr = (pat == 0) ? 1 : (pat == 1) ? 4 : 16;
                    int s, rho, qb;
                    if (r2 < 64) { s = r2 >> 4; const int w = r2 & 15, nb = 16 / rr; rho = w / nb; qb = w % nb; }
                    else { s = 4; const int w = r2 - 64, nb = 32 / rr; rho = w / nb; qb = w % nb; }
                    const int rb = (s < 4) ? s * TP : MP, T = (s < 4) ? TP : TS, L = T / rr;
                    const bf16* base = QKV + (size_t)(rb + rho) * INW;
                    u.q = base + C_QB + 64 * hh; u.k = base + C_KB + 64 * hh; u.v = base + C_VB + 64 * hh; u.rs = (long)rr * INW;
                    u.q0 = qb * 256; u.W = 64; u.hcol = 8 + hh; u.rmul = rr; u.wsh = 3; u.res = 3;
                    int k0 = u.q0 - 64, k1 = u.q0 + 320; if (k0 < 0) k0 = 0; if (k1 > L) k1 = L;
                    if (((k1 - k0) >> 6) & 1) { if (k1 + 64 <= L) k1 += 64; else k0 -= 64; }
                    u.kv0 = k0; u.nt = (k1 - k0) / 64;
                    u.o = BSC + ((size_t)pat * M + rb + rho) * 512 + 64 * hh; u.ors = (long)rr * 512;
                    u.lse = BLSE + ((size_t)pat * M + rb + rho) * 8 + hh; u.lrs = (long)rr * 8;
                    u.mfix = QKB(1) + BIASMAX(8 + hh);
                    att::attn_dense<2>(u, lds, relpos);
                }
            }
        }
        SEAM(p0 + 2);
        if (IN(p0 + 3) && !SKIP_CMB) for (int rep = 0; rep < REP_CMB; ++rep) {
            int lane = threadIdx.x & 63; asm volatile("" : "+v"(lane));
            const float lam_init = 0.8f - 0.6f * expf(-0.3f * (float)l);
            const float* dl = a.in[I_DLAM] + l * 256;
            const float s1 = wave_sum(dl[lane] * dl[64 + lane]), s2 = wave_sum(dl[128 + lane] * dl[192 + lane]);
            const float lam = expf(s1) - expf(s2) + lam_init;
            const float* sub = a.in[I_DSUB] + l * 128;
            const int hC = lane >> 4, dC = (lane & 15) * 8, hB = lane >> 3, dB = (lane & 7) * 8;
            const f32x4 sg0 = *(const f32x4*)(sub + dC) * (1.0f - lam_init), sg1 = *(const f32x4*)(sub + dC + 4) * (1.0f - lam_init);
            for (int r = gw; r < M; r += NGW) {
                { const bf16* p0_ = CSC + ((size_t)r * 8 + hC * 2) * 128 + dC; const u32x4 w0 = __builtin_nontemporal_load((const u32x4*)p0_), w1 = __builtin_nontemporal_load((const u32x4*)(p0_ + 128));
                  float a[8];
#pragma unroll
                  for (int j = 0; j < 4; ++j) { a[2 * j] = __uint_as_float(w0[j] << 16) - lam * __uint_as_float(w1[j] << 16); a[2 * j + 1] = __uint_as_float(w0[j] & 0xffff0000u) - lam * __uint_as_float(w1[j] & 0xffff0000u); }
                  float ss = 0.f;
#pragma unroll
                  for (int j = 0; j < 8; ++j) ss += a[j] * a[j];
                  ss += __shfl_xor(ss, 1); ss += __shfl_xor(ss, 2); ss += __shfl_xor(ss, 4); ss += __shfl_xor(ss, 8);
                  const float rstd = 1.0f / sqrtf(ss * (1.0f / 128.0f) + 1e-6f);
                  u32x4 w; w.x = cvtpk(a[0] * rstd * sg0[0], a[1] * rstd * sg0[1]); w.y = cvtpk(a[2] * rstd * sg0[2], a[3] * rstd * sg0[3]);
                  w.z = cvtpk(a[4] * rstd * sg1[0], a[5] * rstd * sg1[1]); w.w = cvtpk(a[6] * rstd * sg1[2], a[7] * rstd * sg1[3]);
                  *(u32x4*)(MIX + (size_t)r * DM + 1024 + hC * 128 + dC) = w; }
                { const float e0 = BLSE[((size_t)0 * M + r) * 8 + hB], e1 = BLSE[((size_t)1 * M + r) * 8 + hB], e2 = BLSE[((size_t)2 * M + r) * 8 + hB];
                  const float mx = fmaxf(e0, fmaxf(e1, e2));
                  float w0 = __builtin_amdgcn_exp2f(e0 - mx), w1 = __builtin_amdgcn_exp2f(e1 - mx), w2 = __builtin_amdgcn_exp2f(e2 - mx);
                  const float iw = 1.0f / (w0 + w1 + w2); w0 *= iw; w1 *= iw; w2 *= iw;
                  const u32x4 q0_ = __builtin_nontemporal_load((const u32x4*)(BSC + ((size_t)0 * M + r) * 512 + hB * 64 + dB)), q1_ = __builtin_nontemporal_load((const u32x4*)(BSC + ((size_t)1 * M + r) * 512 + hB * 64 + dB)), q2_ = __builtin_nontemporal_load((const u32x4*)(BSC + ((size_t)2 * M + r) * 512 + hB * 64 + dB));
                  u32x4 w;
#pragma unroll
                  for (int j = 0; j < 4; ++j) {
                      const float lo = __uint_as_float(q0_[j] << 16) * w0 + __uint_as_float(q1_[j] << 16) * w1 + __uint_as_float(q2_[j] << 16) * w2;
                      const float hi2 = __uint_as_float(q0_[j] & 0xffff0000u) * w0 + __uint_as_float(q1_[j] & 0xffff0000u) * w1 + __uint_as_float(q2_[j] & 0xffff0000u) * w2;
                      w[j] = cvtpk(lo, hi2); }
                  *(u32x4*)(MIX + (size_t)r * DM + 512 + hB * 64 + dB) = w; }
            }
        }
        SEAM(p0 + 3);
        if (IN(p0 + 4) && !SKIP_GOUT) for (int rep = 0; rep < REP_GRES; ++rep) {
            pg8::Gemm g{MIX, Wout_t + (size_t)l * DM * DM, M, DM, DM}; pg8::StaticOrder S; S.init(M, DM, G, bx);
            const int s32 = (l == 0 && rep == 0) ? 1 : 0;
            pg8::EpiResid E{XB, s32 ? (const void*)a.in[I_XP] : (const void*)XB, s32 ? (const void*)a.in[I_XS] : (const void*)(XB + (size_t)MP * DM), modl + 2 * DM, rep == 0 ? 1.0f : 0.0f, s32, 0, 0};
            pg8::gemm_phase<pg8::EpiResid>(lds, g, S, E);
        }
        SEAM(p0 + 4);
        if (IN(p0 + 5) && !SKIP_NORM) { for (int rep = 0; rep < REP_NORM; ++rep) NORM_PHASE(1); }
        SEAM(p0 + 5);
        if (IN(p0 + 6) && !SKIP_GGU) for (int rep = 0; rep < REP_GGU; ++rep) {
            pg8::Gemm g{Hb, Wgu_t + (size_t)l * 2 * FF * DM, M, 2 * FF, DM}; pg8::StaticOrder S; S.init(M, 2 * FF, G, bx);
            pg8::EpiSwiglu E{ACT};
            pg8::gemm_phase<pg8::EpiSwiglu>(lds, g, S, E);
        }
        SEAM(p0 + 6);
        if (IN(p0 + 7) && !SKIP_GDN) for (int rep = 0; rep < REP_GRES; ++rep) {
            pg8::Gemm g{ACT, Wdn_t + (size_t)l * DM * FF, M, DM, FF}; pg8::StaticOrder S; S.init(M, DM, G, bx);
            const int d32 = (l + 1 == DEPTH) ? 1 : 0;
            pg8::EpiResid E{d32 ? (void*)X : (void*)XB, XB, XB + (size_t)MP * DM, modl + 5 * DM, rep == 0 ? 1.0f : 0.0f, 0, d32, 0};
            pg8::gemm_phase<pg8::EpiResid>(lds, g, S, E);
        }
        SEAM(p0 + 7);
    }
#undef IN
#undef SEAM
#undef NORM_PHASE
}

extern "C" void kernel_launch(void* const* d_in, const int* in_sizes, int n_in, void* d_out, int out_size, void* d_ws, size_t ws_size, hipStream_t stream) {
    static int grid = 0;
    if (grid == 0) {
        if (n_in != 17 || out_size != M * DM || ws_size < WS_END) { fprintf(stderr, "kernel_launch: unexpected shapes (n_in %d out %d ws %zu)\n", n_in, out_size, ws_size); grid = -1; return; }
        int dev = 0, cus = 0, per_cu = 0;
        if (hipGetDevice(&dev) != hipSuccess || hipDeviceGetAttribute(&cus, hipDeviceAttributeMultiprocessorCount, dev) != hipSuccess) { grid = -1; return; }
        if (hipFuncSetAttribute((const void*)mega_fwd, hipFuncAttributeMaxDynamicSharedMemorySize, LDS_BYTES) != hipSuccess) { fprintf(stderr, "kernel_launch: hipFuncSetAttribute failed\n"); grid = -1; return; }
        if (hipOccupancyMaxActiveBlocksPerMultiprocessor(&per_cu, (const void*)mega_fwd, 512, LDS_BYTES) != hipSuccess || per_cu < 1) { fprintf(stderr, "kernel_launch: occupancy query says %d\n", per_cu); }
        (void)hipGetLastError();
        grid = cus;
    }
    if (grid < 0) return;
    (void)hipMemsetAsync((char*)d_ws + WS_CTL, 0, CTL_ZERO_BYTES, stream);
    Args a{};
    for (int i = 0; i < 17; ++i) a.in[i] = (const float*)d_in[i];
    a.out = (float*)d_out; a.ws = (unsigned char*)d_ws;
    const int NPH = 1 + 8 * DEPTH;
#if MK_PER_PHASE
    for (int p = 0; p < NPH; ++p) { a.ph_lo = p; a.ph_hi = p + 1; hipLaunchKernelGGL(mega_fwd, dim3(grid), dim3(512), LDS_BYTES, stream, a); }
#else
    a.ph_lo = 0; a.ph_hi = NPH;
    hipLaunchKernelGGL(mega_fwd, dim3(grid), dim3(512), LDS_BYTES, stream, a);
#endif
}
```

```cpp
#include <hip/hip_runtime.h>
#include <cstdio>
#include <cstdint>

#ifndef MK_PER_PHASE
#define MK_PER_PHASE 0
#endif


#ifndef SKIP_PRO
#define SKIP_PRO 0
#endif
#ifndef SKIP_NORM
#define SKIP_NORM 0
#endif
#ifndef SKIP_GIN
#define SKIP_GIN 0
#endif
#ifndef SKIP_ATT
#define SKIP_ATT 0
#endif
#ifndef SKIP_CMB
#define SKIP_CMB 0
#endif
#ifndef SKIP_GOUT
#define SKIP_GOUT 0
#endif
#ifndef SKIP_GGU
#define SKIP_GGU 0
#endif
#ifndef SKIP_GDN
#define SKIP_GDN 0
#endif

#ifndef REP_NORM
#define REP_NORM 1
#endif
#ifndef REP_GIN
#define REP_GIN 1
#endif
#ifndef REP_ATT
#define REP_ATT 1
#endif
#ifndef REP_CMB
#define REP_CMB 1
#endif
#ifndef REP_GRES
#define REP_GRES 1
#endif
#ifndef REP_PRO
#define REP_PRO 1
#endif
#ifndef ATT_REP_MASK
#define ATT_REP_MASK 0
#endif
#ifndef REP_GGU
#define REP_GGU 1
#endif
#define GAS __attribute__((address_space(1)))
#define LAS __attribute__((address_space(3)))
typedef unsigned short bf16;
typedef short bf16x8 __attribute__((ext_vector_type(8)));
typedef short s16x4 __attribute__((ext_vector_type(4)));
typedef float f32x2 __attribute__((ext_vector_type(2)));
typedef float f32x4 __attribute__((ext_vector_type(4)));
typedef float f32x16 __attribute__((ext_vector_type(16)));
typedef unsigned u32x2 __attribute__((ext_vector_type(2)));
typedef unsigned u32x4 __attribute__((ext_vector_type(4)));
typedef __bf16 bf16x2_t __attribute__((ext_vector_type(2)));

constexpr int DM = 2048, TP = 4096, TS = 8192, MP = 16384, M = 24576, DEPTH = 4, NSEQ = 5;
constexpr int INW = 4608, FF = 5632, NMOD = 12288;
constexpr int C_QA = 0, C_KA = 512, C_VA = 640, C_QB = 768, C_KB = 1280, C_VB = 1792, C_QC = 2304, C_KC = 2816, C_VC = 3328, C_QD = 3840, C_KD = 4352, C_VD = 4480;
constexpr float LOG2E = 1.4426950408889634f;
constexpr float QSCALE = 0.125f * LOG2E;
constexpr float NEG_BIG = -1e30f, M_INIT = -30000.f;

constexpr size_t MiB = 1u << 20;
constexpr size_t WS_CTL = 0, CTL_ZERO_BYTES = 64 * 1024;
constexpr size_t WS_MOD = 1 * MiB;
constexpr size_t WS_ROPE = 2 * MiB;
constexpr size_t WS_WIN = 4 * MiB;
constexpr size_t WS_WOUT = 76 * MiB;
constexpr size_t WS_WGU = 108 * MiB;
constexpr size_t WS_WDN = 284 * MiB;
constexpr size_t WS_H = 372 * MiB;
constexpr size_t WS_QKV = 468 * MiB;
constexpr size_t WS_MIX = 684 * MiB;
constexpr size_t WS_BSC = 780 * MiB;
constexpr size_t WS_BLSE = 852 * MiB;
constexpr size_t WS_CSC = 855 * MiB;
constexpr size_t WS_XB = 903 * MiB;
constexpr size_t WS_ACT = 999 * MiB;
constexpr size_t WS_END = 1263 * MiB;
constexpr int CW_BAR = 1024;

constexpr int RING_BYTES = 131072;
constexpr int MISC_OFF = RING_BYTES;
constexpr int LDS_BYTES = 147456;

__device__ __forceinline__ unsigned cvtpk(float lo, float hi) { f32x2 v = {lo, hi}; bf16x2_t b = __builtin_convertvector(v, bf16x2_t); return __builtin_bit_cast(unsigned, b); }
__device__ __forceinline__ float wave_sum(float v) {
#pragma unroll
    for (int o = 1; o < 64; o <<= 1) v += __shfl_xor(v, o);
    return v;
}
__device__ __forceinline__ int seq_of_row(int r) { return r < MP ? (r >> 12) : 4; }
__device__ __forceinline__ int pos_of_row(int r) { return r < MP ? (r & (TP - 1)) : (r - MP); }

#define XB_TMO      128
#define XB_XCNT(j)  (256  + 64 * (j))
#define XB_XSUB(j)  (1280 + 64 * (j))
#define XB_XGEN(j)  (2304 + 64 * (j))
#define XB_TOP      3328
#define XB_TOPGEN   3392
#define XCD_BAR_WORDS 3456
#define XB_SPIN_CAP (1u << 18)
__device__ __forceinline__ unsigned xb_ld(unsigned* p)              { return __hip_atomic_load(p, __ATOMIC_RELAXED, __HIP_MEMORY_SCOPE_AGENT); }
__device__ __forceinline__ unsigned xb_add(unsigned* p, unsigned v) { return __hip_atomic_fetch_add(p, v, __ATOMIC_RELAXED, __HIP_MEMORY_SCOPE_AGENT); }
__device__ __forceinline__ unsigned xb_xcc_id() { return (unsigned)__builtin_amdgcn_s_getreg((3 << 11) | 20) & 0xFu; }
#define XB_SPIN(cond, bar) do { unsigned _sp = 0; while (cond) { __builtin_amdgcn_s_sleep(1); \
    if ((++_sp & 255u) == 0u) { if (xb_ld(&(bar)[XB_TMO])) break; if (_sp > XB_SPIN_CAP) { atomicAdd(&(bar)[XB_TMO], 1u); break; } } } } while (0)
struct XcdBarrier { unsigned* bar; unsigned x; volatile LAS unsigned* st; };
__device__ __forceinline__ XcdBarrier xcd_barrier_post(unsigned* bar, volatile LAS unsigned* st) {
    XcdBarrier b; b.bar = bar; b.x = xb_xcc_id(); b.st = st;
    if (threadIdx.x == 0) (void)xb_add(&bar[XB_XCNT(b.x)], 1u);
    return b;
}
__device__ __forceinline__ void xcd_barrier_complete(unsigned* bar, unsigned x, unsigned& nloc, unsigned& nx) {
    const unsigned G = gridDim.x * gridDim.y * gridDim.z;
    unsigned sum, cnt, mine, sp = 0u;
    for (;;) {
        sum = 0u; cnt = 0u; mine = 0u;
#pragma unroll
        for (unsigned j = 0; j < 16; ++j) { const unsigned c = xb_ld(&bar[XB_XCNT(j)]); sum += c; cnt += (c > 0u) ? 1u : 0u; mine = (j == x) ? c : mine; }
        if (sum == G) break;
        __builtin_amdgcn_s_sleep(1);
        if ((++sp & 255u) == 0u) { if (xb_ld(&bar[XB_TMO])) break; if (sp > XB_SPIN_CAP) { atomicAdd(&bar[XB_TMO], 1u); break; } }
    }
    nloc = mine > 0u ? mine : 1u; nx = cnt > 0u ? cnt : 1u;
}
__device__ __forceinline__ void xcd_barrier(const XcdBarrier& b) {
    asm volatile("s_waitcnt vmcnt(0)" ::: "memory");
    __syncthreads();
    if (threadIdx.x == 0) {
        unsigned* bar = b.bar;
        __builtin_amdgcn_s_waitcnt(0);
        unsigned nloc = b.st[0], nx = b.st[1];
        if (nloc == 0u) { xcd_barrier_complete(bar, b.x, nloc, nx); b.st[0] = nloc; b.st[1] = nx; }
        const unsigned old = xb_add(&bar[XB_XSUB(b.x)], 1u);
        const unsigned gen = old / nloc;
        if (old + 1u == (gen + 1u) * nloc) {
            __builtin_amdgcn_fence(__ATOMIC_RELEASE, "agent");
            asm volatile("s_waitcnt vmcnt(0)" ::: "memory");
            const unsigned og = xb_add(&bar[XB_TOP], 1u);
            const unsigned tg = og / nx;
            if (og + 1u == (tg + 1u) * nx) xb_add(&bar[XB_TOPGEN], 1u);
            else XB_SPIN(xb_ld(&bar[XB_TOPGEN]) == tg, bar);
            __builtin_amdgcn_fence(__ATOMIC_ACQUIRE, "agent");
            xb_add(&bar[XB_XGEN(b.x)], 1u);
            asm volatile("s_waitcnt vmcnt(0)" ::: "memory");
        } else {
            XB_SPIN(xb_ld(&bar[XB_XGEN(b.x)]) == gen, bar);
            __builtin_amdgcn_fence(__ATOMIC_ACQUIRE, "agent");
            asm volatile("s_waitcnt vmcnt(0)" ::: "memory");
        }
    }
    __syncthreads();
}

namespace pg8 {
constexpr int BM = 256, BK = 64, HALF = 128, HTB = HALF * BK * 2, STAGE_BYTES = 8 * HTB, NXCD = 8, WGM = 4;
__host__ __device__ __forceinline__ int lds_byte(int r, int c) { const int st = (r >> 4) * 2 + (c >> 5), rr = r & 15, cc = c & 31, ob = rr * 64 + cc * 2; return st * 1024 + (ob ^ (((ob >> 9) & 1) << 5)); }
__host__ __device__ __forceinline__ void stage_rc(int b, int& R, int& C) { const int st = b / 1024, sb = b % 1024, swz = sb ^ (((sb >> 9) & 1) << 5); R = (st >> 1) * 16 + swz / 64; C = (st & 1) * 32 + (swz % 64) / 2; }
struct Unit { int pm, pn; };
struct Gemm { const bf16* A; const bf16* Bt; int M, N, K; };
struct StaticOrder {
    int nM, nN, nwg, G, c;
    __host__ __device__ void init(int M_, int N_, int G_, int c_) { nM = M_ / BM; nN = N_ / BM; nwg = nM * nN; G = G_; c = c_; }
    __host__ __device__ bool next(int i, Unit& u) const {
        const long L = (long)i * G + c; if (L >= nwg) return false;
        int wgid = (int)L; { const int q = nwg / NXCD, r = nwg % NXCD, xcd = wgid % NXCD, off = wgid / NXCD; wgid = (xcd < r ? xcd * (q + 1) : r * (q + 1) + (xcd - r) * q) + off; }
        const int nig = WGM * nN, gid = wgid / nig, fm = gid * WGM, gsz = (nM - fm) < WGM ? (nM - fm) : WGM;
        u.pm = fm + ((wgid % nig) % gsz); u.pn = (wgid % nig) / gsz; return true;
    }
};
template <class Epi>
__device__ __forceinline__ void gemm_phase(LAS unsigned char* lds, const Gemm g, const StaticOrder& S, const Epi& E) {
    int tid = threadIdx.x; asm volatile("" : "+v"(tid));
    const int wid = __builtin_amdgcn_readfirstlane(tid >> 6), lane = tid & 63, wr = wid >> 2, wc = wid & 3, fr = lane & 15, fq = lane >> 4;
    const int K = g.K, nt = K / BK;
    unsigned voffA[2];
#pragma unroll
    for (int i = 0; i < 2; ++i) { int R, C; stage_rc(tid * 16 + i * 8192, R, C); voffA[i] = (unsigned)(R * K + C) * 2u; }
    const size_t kstep = (size_t)(BK * 2);
    const size_t hstep = (size_t)HALF * K * 2;
    const size_t tstep = 2 * hstep;
    const unsigned ldsw = (unsigned)wid * 1024u;
    const int aoff = lds_byte(wr * 64 + fr, fq * 8), boff = lds_byte(wc * 32 + fr, fq * 8);
#define PG8_SA(b, h) (((b) * 2 + (h)) * HTB)
#define PG8_SB(b, h) ((4 + (b) * 2 + (h)) * HTB)
#define PG8_STAGE(bufoff, gbase) do { _Pragma("unroll") for (int _i = 0; _i < 2; ++_i) \
        __builtin_amdgcn_global_load_lds((const unsigned*)((const char*)(gbase) + voffA[_i]), (LAS unsigned*)(lds + (bufoff) + ldsw + _i * 8192), 16, 0, 0); } while (0)
#define PG8_LDA(dst, b, h) do { _Pragma("unroll") for (int m = 0; m < 4; ++m) _Pragma("unroll") for (int k = 0; k < 2; ++k) dst[m][k] = *(const LAS bf16x8*)(lds + PG8_SA(b, h) + aoff + m * 2048 + k * 1024); } while (0)
#define PG8_LDB(dst, b, h) do { _Pragma("unroll") for (int n = 0; n < 2; ++n) _Pragma("unroll") for (int k = 0; k < 2; ++k) dst[n][k] = *(const LAS bf16x8*)(lds + PG8_SB(b, h) + boff + n * 2048 + k * 1024); } while (0)
#define PG8_MMA(ai, bj, At, Bt) do { __builtin_amdgcn_s_setprio(1); _Pragma("unroll") for (int m = 0; m < 4; ++m) _Pragma("unroll") for (int n = 0; n < 2; ++n) _Pragma("unroll") for (int k = 0; k < 2; ++k) \
        acc[ai][bj][m][n] = __builtin_amdgcn_mfma_f32_16x16x32_bf16(Bt[n][k], At[m][k], acc[ai][bj][m][n], 0, 0, 0); __builtin_amdgcn_s_setprio(0); } while (0)
#define PG8_WAIT_V(n) asm volatile("s_waitcnt vmcnt(" #n ")" ::: "memory")
#define PG8_WAIT_L(n) asm volatile("s_waitcnt lgkmcnt(" #n ")" ::: "memory")
#define PG8_BAR __builtin_amdgcn_s_barrier()
#define PG8_SCHED __builtin_amdgcn_sched_barrier(0)
    Unit cur, nxt; int ui = 0;
    if (!S.next(0, cur)) return;
    f32x4 acc[2][2][4][2];
#pragma unroll
    for (int a = 0; a < 2; ++a)
#pragma unroll
        for (int b = 0; b < 2; ++b)
#pragma unroll
            for (int m = 0; m < 4; ++m)
#pragma unroll
                for (int n = 0; n < 2; ++n) acc[a][b][m][n] = (f32x4){0.f, 0.f, 0.f, 0.f};
    bf16x8 At[4][2], B0[2][2], B1[2][2];
    const char* cA = (const char*)g.A + (size_t)cur.pm * tstep; const char* cB = (const char*)g.Bt + (size_t)cur.pn * tstep;
    PG8_STAGE(PG8_SB(0, 0), cB); PG8_STAGE(PG8_SB(0, 1), cB + hstep); PG8_STAGE(PG8_SA(0, 0), cA); PG8_STAGE(PG8_SA(0, 1), cA + hstep);
    if (wr == 1) PG8_BAR;
    PG8_WAIT_V(2); PG8_BAR;
    PG8_STAGE(PG8_SB(1, 0), cB + kstep); PG8_STAGE(PG8_SA(1, 0), cA + kstep); PG8_STAGE(PG8_SB(1, 1), cB + hstep + kstep);
    PG8_WAIT_V(6); PG8_BAR;
    for (;;) {
        const bool has_next = S.next(ui + 1, nxt);
        const char* nA = has_next ? (const char*)g.A + (size_t)nxt.pm * tstep : cA; const char* nB = has_next ? (const char*)g.Bt + (size_t)nxt.pn * tstep : cB;
        for (int t = 0; t < nt; t += 2) {
            const bool last = (t == nt - 2);
            const char* a1 = cA + (size_t)(t + 1) * kstep;
            const char* a2 = last ? nA : cA + (size_t)(t + 2) * kstep; const char* b2 = last ? nB : cB + (size_t)(t + 2) * kstep;
            const char* a3 = a2 + kstep; const char* b3 = b2 + kstep;
            PG8_LDB(B0, 0, 0); PG8_LDB(B1, 0, 1); PG8_SCHED; PG8_LDA(At, 0, 0); PG8_STAGE(PG8_SA(1, 1), a1 + hstep);
            PG8_WAIT_V(8); PG8_WAIT_L(0); PG8_BAR; PG8_MMA(0, 0, At, B0); PG8_MMA(0, 1, At, B1); PG8_BAR; PG8_SCHED;
            PG8_LDA(At, 0, 1); PG8_STAGE(PG8_SB(0, 0), b2); PG8_STAGE(PG8_SB(0, 1), b2 + hstep); PG8_STAGE(PG8_SA(0, 0), a2);
            PG8_WAIT_V(8); PG8_WAIT_L(0); PG8_BAR; PG8_MMA(1, 0, At, B0); PG8_MMA(1, 1, At, B1); PG8_BAR; PG8_SCHED;
            PG8_LDB(B0, 1, 0); PG8_LDB(B1, 1, 1); PG8_SCHED; PG8_LDA(At, 1, 0); PG8_STAGE(PG8_SA(0, 1), a2 + hstep);
            PG8_WAIT_V(8); PG8_WAIT_L(0); PG8_BAR; PG8_MMA(0, 0, At, B0); PG8_MMA(0, 1, At, B1); PG8_BAR; PG8_SCHED;
            PG8_LDA(At, 1, 1); PG8_STAGE(PG8_SB(1, 0), b3); PG8_STAGE(PG8_SB(1, 1), b3 + hstep); PG8_STAGE(PG8_SA(1, 0), a3);
            PG8_WAIT_V(8); PG8_WAIT_L(0); PG8_BAR; PG8_MMA(1, 0, At, B0); PG8_MMA(1, 1, At, B1); PG8_BAR; PG8_SCHED;
        }
        if (wr == 0) PG8_BAR;
        E(acc, cur, wr, wc, fr, fq);
        if (!has_next) break;
#pragma unroll
        for (int a = 0; a < 2; ++a)
#pragma unroll
            for (int b = 0; b < 2; ++b)
#pragma unroll
                for (int m = 0; m < 4; ++m)
#pragma unroll
                    for (int n = 0; n < 2; ++n) acc[a][b][m][n] = (f32x4){0.f, 0.f, 0.f, 0.f};
        cur = nxt; cA = nA; cB = nB; ++ui;
        if (wr == 1) PG8_BAR;
    }
    PG8_WAIT_V(0);
    PG8_BAR;
#undef PG8_SA
#undef PG8_SB
#undef PG8_STAGE
#undef PG8_LDA
#undef PG8_LDB
#undef PG8_MMA
#undef PG8_WAIT_V
#undef PG8_WAIT_L
#undef PG8_BAR
#undef PG8_SCHED
}

struct EpiQKV {
    bf16* O; const float* gains  ; const float2* rope  ;
    __device__ __forceinline__ void operator()(f32x4 (&acc)[2][2][4][2], const Unit& u, int wr, int wc, int fr, int fq) const {
        const int hg = u.pn * 4 + wc;
        int gi = -1; bool isq = false, rp = false;
        if (hg < 8) { gi = 0; isq = true; } else if (hg < 10) gi = 1; else if (hg < 12) gi = -1;
        else if (hg < 20) { gi = 2; isq = true; } else if (hg < 28) gi = 3; else if (hg < 36) gi = -1;
        else if (hg < 44) { gi = 4; isq = true; } else if (hg < 52) gi = 5; else if (hg < 60) gi = -1;
        else if (hg < 68) { gi = 6; isq = true; rp = true; } else if (hg < 70) { gi = 7; rp = true; }
        f32x4 gv[2][2];
#pragma unroll
        for (int bj = 0; bj < 2; ++bj)
#pragma unroll
            for (int n = 0; n < 2; ++n) { gv[bj][n] = (gi >= 0) ? *(const f32x4*)(gains + gi * 64 + 32 * (fq & 1) + 16 * n + 8 * (fq >> 1) + 4 * bj) : (f32x4){1.f, 1.f, 1.f, 1.f}; if (isq) gv[bj][n] = gv[bj][n] * QSCALE; }
#pragma unroll
        for (int ai = 0; ai < 2; ++ai)
#pragma unroll
            for (int m = 0; m < 4; ++m) {
                const int row = u.pm * BM + ai * HALF + wr * 64 + m * 16 + fr;
                f32x4 v[2][2];
#pragma unroll
                for (int bj = 0; bj < 2; ++bj)
#pragma unroll
                    for (int n = 0; n < 2; ++n) v[bj][n] = acc[ai][bj][m][n];
                float rstd = 1.f;
                if (gi >= 0) {
                    float ss = 0.f;
#pragma unroll
                    for (int bj = 0; bj < 2; ++bj)
#pragma unroll
                        for (int n = 0; n < 2; ++n) ss += (v[bj][n][0] * v[bj][n][0] + v[bj][n][1] * v[bj][n][1]) + (v[bj][n][2] * v[bj][n][2] + v[bj][n][3] * v[bj][n][3]);
                    ss += __shfl_xor(ss, 16); ss += __shfl_xor(ss, 32);
                    rstd = __builtin_amdgcn_rsqf(ss * (1.0f / 64.0f) + 1e-6f);
                }
#pragma unroll
                for (int bj = 0; bj < 2; ++bj)
#pragma unroll
                    for (int n = 0; n < 2; ++n) v[bj][n] = v[bj][n] * (gv[bj][n] * rstd);
                if (rp) {
                    const int t = pos_of_row(row);
                    const int pos = (fq & 1) ? (t & 63) : (t >> 6);
#pragma unroll
                    for (int bj = 0; bj < 2; ++bj) {
                        const float2* rp_ = rope + pos * 16 + 8 * (fq >> 1) + 4 * bj;
                        const f32x4 cs0 = *(const f32x4*)rp_, cs1 = *(const f32x4*)(rp_ + 2);
                        const float c[4] = {cs0[0], cs0[2], cs1[0], cs1[2]}, s[4] = {cs0[1], cs0[3], cs1[1], cs1[3]};
#pragma unroll
                        for (int i = 0; i < 4; ++i) { const float x1 = v[bj][0][i], x2 = v[bj][1][i]; v[bj][0][i] = x1 * c[i] - x2 * s[i]; v[bj][1][i] = x2 * c[i] + x1 * s[i]; }
                    }
                }
                bf16* rowp = O + (size_t)row * INW + hg * 64 + 32 * (fq & 1) + 8 * (fq >> 1);
#pragma unroll
                for (int n = 0; n < 2; ++n) { u32x4 w; w.x = cvtpk(v[0][n][0], v[0][n][1]); w.y = cvtpk(v[0][n][2], v[0][n][3]); w.z = cvtpk(v[1][n][0], v[1][n][1]); w.w = cvtpk(v[1][n][2], v[1][n][3]);
                    *(u32x4*)(rowp + 16 * n) = w; }
            }
    }
};
struct EpiResid {
    void* dst; const void* srcp; const void* srcs;
    const float* gate  ; float gsc; int src_f32, dst_f32, pad_;
    __device__ __forceinline__ void operator()(f32x4 (&acc)[2][2][4][2], const Unit& u, int wr, int wc, int fr, int fq) const {
        const int b = seq_of_row(u.pm * BM);
        const int col0 = u.pn * BM + wc * 32 + fq * 8;
        const float* gvec = gate + (size_t)b * (6 * DM) + col0;
        f32x4 gv[2][2];
#pragma unroll
        for (int bj = 0; bj < 2; ++bj)
#pragma unroll
            for (int n = 0; n < 2; ++n) gv[bj][n] = *(const f32x4*)(gvec + bj * HALF + n * 4) * gsc;
#pragma unroll
        for (int am = 0; am < 4; ++am) {
            const int ai = am >> 1;
            f32x4 xv[2][2][2];
#pragma unroll
            for (int mm = 0; mm < 2; ++mm) { const int m = (am & 1) * 2 + mm; const int row = u.pm * BM + ai * HALF + wr * 64 + m * 16 + fr;
                const size_t eo = ((row < MP) ? (size_t)row : (size_t)(row - MP)) * DM + col0;
                if (src_f32) { const float* rp = (const float*)((row < MP) ? srcp : srcs) + eo;
#pragma unroll
                    for (int bj = 0; bj < 2; ++bj)
#pragma unroll
                        for (int n = 0; n < 2; ++n) xv[mm][bj][n] = *(const f32x4*)(rp + bj * HALF + n * 4); }
                else { const bf16* rp = (const bf16*)((row < MP) ? srcp : srcs) + eo;
#pragma unroll
                    for (int bj = 0; bj < 2; ++bj) { const u32x4 w = *(const u32x4*)(rp + bj * HALF);
                        xv[mm][bj][0] = (f32x4){__uint_as_float(w.x << 16), __uint_as_float(w.x & 0xffff0000u), __uint_as_float(w.y << 16), __uint_as_float(w.y & 0xffff0000u)};
                        xv[mm][bj][1] = (f32x4){__uint_as_float(w.z << 16), __uint_as_float(w.z & 0xffff0000u), __uint_as_float(w.w << 16), __uint_as_float(w.w & 0xffff0000u)}; } }
            }
#pragma unroll
            for (int mm = 0; mm < 2; ++mm) { const int m = (am & 1) * 2 + mm; const size_t eo = (size_t)(u.pm * BM + ai * HALF + wr * 64 + m * 16 + fr) * DM + col0;
#pragma unroll
                for (int bj = 0; bj < 2; ++bj) { const f32x4 x0 = xv[mm][bj][0] + gv[bj][0] * acc[ai][bj][m][0], x1 = xv[mm][bj][1] + gv[bj][1] * acc[ai][bj][m][1];
                    if (dst_f32) { *(f32x4*)((float*)dst + eo + bj * HALF) = x0; *(f32x4*)((float*)dst + eo + bj * HALF + 4) = x1; }
                    else { u32x4 w; w.x = cvtpk(x0[0], x0[1]); w.y = cvtpk(x0[2], x0[3]); w.z = cvtpk(x1[0], x1[1]); w.w = cvtpk(x1[2], x1[3]); *(u32x4*)((bf16*)dst + eo + bj * HALF) = w; } }
            }
            asm volatile("" ::: "memory");
        }
    }
};
struct EpiSwiglu {
    bf16* O;
    __device__ __forceinline__ void operator()(f32x4 (&acc)[2][2][4][2], const Unit& u, int wr, int wc, int fr, int fq) const {
#pragma unroll
        for (int ai = 0; ai < 2; ++ai)
#pragma unroll
            for (int m = 0; m < 4; ++m) {
                const int row = u.pm * BM + ai * HALF + wr * 64 + m * 16 + fr;
                float a[2][4];
#pragma unroll
                for (int bj = 0; bj < 2; ++bj)
#pragma unroll
                    for (int i = 0; i < 4; ++i) { const float gg = acc[ai][bj][m][0][i], uu = acc[ai][bj][m][1][i]; a[bj][i] = gg * uu * __builtin_amdgcn_rcpf(1.0f + __builtin_amdgcn_exp2f(-gg * LOG2E)); }
                u32x4 w; w.x = cvtpk(a[0][0], a[0][1]); w.y = cvtpk(a[0][2], a[0][3]); w.z = cvtpk(a[1][0], a[1][1]); w.w = cvtpk(a[1][2], a[1][3]);
                *(u32x4*)(O + (size_t)row * FF + u.pn * 128 + wc * 32 + fq * 8) = w;
            }
    }
};
}

namespace att {
constexpr int A_K = 0, A_V = 24576, A_WSF = 73728, A_LUT = 75776, A_END = 92416;
constexpr int LUTW = 1025, LUTC = 512;
struct AU {
    const bf16* q; const bf16* k; const bf16* v; long rs;
    int q0, kv0, nt;
    int W, hcol, rmul;
    void* o; long ors;
    float* lse; long lrs;
    int sink4, has_sink;
    float mfix; int res;
    int wsh, of32;
};
__device__ __forceinline__ int crow(int r, int hi) { return (r & 3) + 8 * (r >> 2) + 4 * hi; }
__device__ __forceinline__ void glds16(const void* gsrc, unsigned lds_dst) { unsigned keep;
    asm volatile("s_mov_b32 %0, m0\n\ts_mov_b32 m0, %2\n\ts_nop 0\n\tglobal_load_lds_dwordx4 %1, off\n\ts_mov_b32 m0, %0" : "=&s"(keep) : "v"(gsrc), "s"(lds_dst) : "memory"); }
#define LDS_ADDR(p) ((unsigned)__builtin_amdgcn_readfirstlane((int)(unsigned)(size_t)(p)))
__device__ __forceinline__ int t5_bucket(int rel) {
    const int n = rel < 0 ? -rel : rel;
    const int v = n < 8 ? n : 8 + (n >= 15) + (n >= 27) + (n >= 50) + (n >= 91) + (n >= 166) + (n >= 305) + (n >= 559);
    return v + (rel > 0 ? 16 : 0);
}
template <int MODE>
__device__ __forceinline__ void attn_dense(const AU& u, LAS unsigned char* lds, const float* __restrict__ relpos) {
    constexpr int DV = (MODE == 1) ? 128 : 64, NDB = DV / 32, VSLOT = 64 * DV * 2, NVP = DV / 64;
    constexpr int CL = 656;
    constexpr int A_Vx = (MODE == 2) ? 49152 : A_V, A_WSFx = (MODE == 2) ? 98304 : A_WSF, A_LUTx = (MODE == 2) ? 100352 : A_LUT;
    constexpr float THR = 8.0f;
    int tid = threadIdx.x; asm volatile("" : "+v"(tid));
    const int lane = tid & 63, r32 = lane & 31, hi = lane >> 5; const int wid = __builtin_amdgcn_readfirstlane(tid >> 6);
    const bf16* ksrc = u.k + (long)(u.kv0 + lane) * u.rs + wid * 8;
    const bf16* vsrc = u.v + (long)(u.kv0 + 16 * (wid & 3) + (lane >> 2)) * u.rs + (wid >> 2) * 32 + (lane & 3) * 8;
    const long tstride = 64 * u.rs;
#define DN_DMA_K(t, slot) glds16(ksrc + (long)(t) * tstride, LDS_ADDR(lds + A_K + (slot) * 8192 + wid * 1024))
#define DN_DMA_V(t, slot) do { \
      glds16(vsrc + (long)(t) * tstride, LDS_ADDR(lds + A_Vx + (slot) * VSLOT + wid * 1024)); \
      if (DV == 128) glds16(vsrc + (long)(t) * tstride + 64, LDS_ADDR(lds + A_Vx + (slot) * VSLOT + (wid + 8) * 1024)); \
    } while (0)
    const bool res = (MODE == 2) && (u.res != 0);
    if (res) { for (int j = 0; j < u.nt; ++j) { DN_DMA_K(j, j); DN_DMA_V(j, j); } }
    else { DN_DMA_K(0, 0); DN_DMA_V(0, 0); DN_DMA_K(1, 1); DN_DMA_K(2, 2); }
    LAS float* lut = (LAS float*)(lds + A_LUTx);
    LAS float* wsf = (LAS float*)(lds + A_WSFx) + wid * 64;
    float bL = 0.f, bR = 0.f;
    if (MODE == 1) {
        for (int i = tid; i < 2 * CL + 1; i += 512) lut[i] = relpos[t5_bucket(i - CL) * 20 + u.hcol] * LOG2E;
        bL = relpos[15 * 20 + u.hcol] * LOG2E; bR = relpos[31 * 20 + u.hcol] * LOG2E;
    }
    const int gh = (MODE == 2) ? (wid >> u.wsh) : 0;
    if (MODE == 2) {
        const int ng = 8 >> u.wsh;
        for (int i = tid; i < ng * LUTW; i += 512) { const int gg = i / LUTW, rel = (i % LUTW) - LUTC; const int ar = rel < 0 ? -rel : rel;
            lut[i] = (ar > u.W) ? NEG_BIG : relpos[t5_bucket(rel * u.rmul) * 20 + u.hcol + gg] * LOG2E; }
        lut += gh * LUTW;
    }
    const int qw = (MODE == 2) ? (u.q0 + 32 * (wid & ((1 << u.wsh) - 1))) : (u.q0 + wid * 32);
    bf16x8 qr[4];
    { const bf16* qp = u.q + (long)(qw + r32) * u.rs + hi * 8 + 64 * gh;
#pragma unroll
      for (int d0 = 0; d0 < 4; ++d0) qr[d0] = *(const bf16x8*)(qp + d0 * 16); }
    const int tlo_ = (qw - u.W - u.kv0) > 0 ? ((qw - u.W - u.kv0) >> 6) : 0;
    const int ta = res ? (tlo_ < u.nt - u.res ? tlo_ : u.nt - u.res) : 0;
    const int nt = res ? u.res : u.nt;
    const int ntd = res ? 0 : u.nt;
    const int kv0w = u.kv0 + 64 * ta;
#define SBAR() __builtin_amdgcn_sched_barrier(0)
#define PIN(x) asm volatile("" : "+v"(x))
#define EX2(v) __builtin_amdgcn_exp2f(v)
#define MFMA32(a, b, c) __builtin_amdgcn_mfma_f32_32x32x16_bf16(a, b, c, 0, 0, 0)
#define DN_KLOAD2(Ks_, j) do { kf[2 * (j)] = *(const LAS bf16x8*)((Ks_) + (j) * 2048); kf[2 * (j) + 1] = *(const LAS bf16x8*)((Ks_) + (j) * 2048 + 512); } while (0)
#define DN_VFRAG(dst, Vs_, db, ks) do { \
      const s16x4 lo_ = __builtin_bit_cast(s16x4, __builtin_amdgcn_ds_read_tr16_b64_v4i16((LAS s16x4*)((Vs_) + ((db) * 4 + (ks)) * 1024))); \
      const s16x4 hh_ = __builtin_bit_cast(s16x4, __builtin_amdgcn_ds_read_tr16_b64_v4i16((LAS s16x4*)((Vs_) + ((db) * 4 + (ks)) * 1024 + 512))); \
      dst = (bf16x8){lo_[0], lo_[1], lo_[2], lo_[3], hh_[0], hh_[1], hh_[2], hh_[3]}; } while (0)
#define DN_KIND(t_) ((MODE == 1) ? ((kv0w + 64 * (t_) + 63 - qw <= -559) ? 2 : (kv0w + 64 * (t_) - qw - 31 >= 559) ? 3 : 1) : (MODE == 2) ? 1 : 0)
#define DN_BIAS(S0, S1, t_) do { const LAS float* lp_ = lut + (kv0w + 64 * (t_) - (qw + r32) + 4 * hi + ((MODE == 2) ? LUTC : CL)); \
      _Pragma("unroll") for (int r = 0; r < 16; ++r) { S0[r] += lp_[(r & 3) + 8 * (r >> 2)]; S1[r] += lp_[32 + (r & 3) + 8 * (r >> 2)]; } } while (0)
#define MX3(a, b, c) __builtin_fmaxf(__builtin_fmaxf((a), (b)), (c))
#define DN_ROWMAX(rm_, S0, S1) do { float ra_ = MX3(S0[0], S0[1], S1[0]), rb_ = MX3(S0[2], S0[3], S1[1]); ra_ = MX3(ra_, S1[2], S1[3]); \
      _Pragma("unroll") for (int r = 4; r < 16; r += 4) { ra_ = MX3(ra_, S0[r], S0[r + 1]); rb_ = MX3(rb_, S0[r + 2], S0[r + 3]); ra_ = MX3(ra_, S1[r], S1[r + 1]); rb_ = MX3(rb_, S1[r + 2], S1[r + 3]); } \
      rm_ = __builtin_fmaxf(ra_, rb_); rm_ = __builtin_fmaxf(rm_, __shfl_xor(rm_, 32)); } while (0)
#define PKW(P, B) cvtpk(P[B], P[(B) + 1])
    const int koff = hi * 1024 + r32 * 16;
    const int voff = ((lane >> 4) & 1) * 32 + (lane & 3) * 8 + (4 * hi + ((lane & 15) >> 2)) * 64;
    const float mfix = u.mfix;
    float l_run = 0.f, cb_cur = 0.f;
    f32x16 o[NDB];
#pragma unroll
    for (int db = 0; db < NDB; ++db)
#pragma unroll
        for (int r = 0; r < 16; ++r) o[db][r] = 0.f;
    f32x16 negm;
    const f32x16 zero16 = {0.f, 0.f, 0.f, 0.f, 0.f, 0.f, 0.f, 0.f, 0.f, 0.f, 0.f, 0.f, 0.f, 0.f, 0.f, 0.f};
#define CINIT ((MODE != 1) ? negm : zero16)
#pragma unroll
    for (int r = 0; r < 16; ++r) negm[r] = -mfix;
    asm volatile("" : "+v"(negm));
    bf16x8 kf[8];
    u32x4 pw0, pw1, pw2, pw3;
    f32x16 pA0, pA1, pB0, pB1;
    asm volatile("s_waitcnt vmcnt(0) lgkmcnt(0)" ::: "memory");
    __builtin_amdgcn_s_barrier();
    asm volatile("" ::: "memory");
#define DN_SETCB(t_) do { const int kind_ = DN_KIND(t_); const float cbn_ = (kind_ == 2) ? bL : (kind_ == 3) ? bR : 0.f; \
        if (MODE == 1) cb_cur = cbn_; } while (0)
    {
        const LAS unsigned char* Ks = lds + A_K + ta * 8192 + koff;
        DN_KLOAD2(Ks, 0); DN_KLOAD2(Ks, 1); DN_KLOAD2(Ks, 2); DN_KLOAD2(Ks, 3);
        DN_SETCB(0);
        pA0 = MFMA32(kf[0], qr[0], CINIT); pA1 = MFMA32(kf[1], qr[0], CINIT);
#pragma unroll
        for (int d0 = 1; d0 < 4; ++d0) { pA0 = MFMA32(kf[2 * d0], qr[d0], pA0); pA1 = MFMA32(kf[2 * d0 + 1], qr[d0], pA1); }
        if (MODE != 0 && DN_KIND(0) == 1) DN_BIAS(pA0, pA1, 0);
        { const float shf = (MODE == 1) ? (cb_cur - mfix) : 0.f;
#pragma unroll
          for (int r = 0; r < 16; ++r) { pA0[r] = EX2(pA0[r] + shf); pA1[r] = EX2(pA1[r] + shf); } }
        asm volatile("s_waitcnt lgkmcnt(0)" ::: "memory");
        if (!res) __builtin_amdgcn_s_barrier();
        asm volatile("" ::: "memory");
        if (!res) { DN_DMA_K(3, 0); DN_DMA_V(1, 1); }
        const LAS unsigned char* Ks1 = lds + A_K + (ta + 1) * 8192 + koff;
        DN_KLOAD2(Ks1, 0); DN_KLOAD2(Ks1, 1); DN_KLOAD2(Ks1, 2); DN_KLOAD2(Ks1, 3);
        if (NVP == 1) asm volatile("s_waitcnt vmcnt(2) lgkmcnt(0)" ::: "memory"); else asm volatile("s_waitcnt vmcnt(3) lgkmcnt(0)" ::: "memory");
        if (!res) __builtin_amdgcn_s_barrier();
        asm volatile("" ::: "memory");
    }
    int sl_prev = ta, sl_cur = ta + 1, sl_next = ta + 2;
    if (wid >= 4) __builtin_amdgcn_s_setprio(1);
#define PAF(k) __builtin_bit_cast(bf16x8, pw##k)
#define GAPA(VI, DB, KS, MF, A0, A1, A2, A3, W0, W1, PW) do { DN_VFRAG(vf[VI], Vs, DB, KS); SBAR(); MF; sacc += A0; sacc += A1; sacc += A2; sacc += A3; PIN(sacc); W0; W1; PIN(PW); SBAR(); } while (0)
#define GAPB4(MF, X, B, KJ) do { MF; X[B] = EX2(X[B]); X[(B) + 1] = EX2(X[(B) + 1]); X[(B) + 2] = EX2(X[(B) + 2]); X[(B) + 3] = EX2(X[(B) + 3]); PIN(X); if ((KJ) >= 0) DN_KLOAD2(Kn, (KJ) < 0 ? 0 : (KJ)); SBAR(); } while (0)
#define GAPB2(MF, X, B, AFTER) do { MF; X[B] = EX2(X[B] + shf); X[(B) + 1] = EX2(X[(B) + 1] + shf); PIN(X); AFTER; SBAR(); } while (0)
#define DN_STEP(P0, P1, C0, C1, t_) do { \
        const LAS unsigned char* Vs = lds + A_Vx + sl_prev * VSLOT + voff; \
        const LAS unsigned char* Kn = lds + A_K + sl_next * 8192 + koff; \
        DN_SETCB(t_); \
        bf16x8 vf[8]; \
        SBAR(); \
        float sacc = P0[0] + P0[1]; \
        GAPA(0, 0, 0, C0 = MFMA32(kf[0], qr[0], CINIT), P0[2], P0[3], P0[4], P0[5],     pw0[0] = PKW(P0, 0),  pw0[1] = PKW(P0, 2),  pw0); \
        GAPA(1, 1, 0, C1 = MFMA32(kf[1], qr[0], CINIT), P0[6], P0[7], P0[8], P0[9],     pw0[2] = PKW(P0, 4),  pw0[3] = PKW(P0, 6),  pw0); \
        GAPA(2, 0, 1, C0 = MFMA32(kf[2], qr[1], C0),   P0[10], P0[11], P0[12], P0[13], pw1[0] = PKW(P0, 8),  pw1[1] = PKW(P0, 10), pw1); \
        GAPA(3, 1, 1, C1 = MFMA32(kf[3], qr[1], C1),   P0[14], P0[15], P1[0], P1[1],   pw1[2] = PKW(P0, 12), pw1[3] = PKW(P0, 14), pw1); \
        GAPA(4, 0, 2, C0 = MFMA32(kf[4], qr[2], C0),   P1[2], P1[3], P1[4], P1[5],     pw2[0] = PKW(P1, 0),  pw2[1] = PKW(P1, 2),  pw2); \
        GAPA(5, 1, 2, C1 = MFMA32(kf[5], qr[2], C1),   P1[6], P1[7], P1[8], P1[9],     pw2[2] = PKW(P1, 4),  pw2[3] = PKW(P1, 6),  pw2); \
        GAPA(6, 0, 3, C0 = MFMA32(kf[6], qr[3], C0),   P1[10], P1[11], P1[12], P1[13], pw3[0] = PKW(P1, 8),  pw3[1] = PKW(P1, 10), pw3); \
        GAPA(7, 1, 3, C1 = MFMA32(kf[7], qr[3], C1),   P1[14], P1[15], 0.f, 0.f,       pw3[2] = PKW(P1, 12), pw3[3] = PKW(P1, 14), pw3); \
        l_run += sacc; \
        if (MODE != 0 && DN_KIND(t_) == 1) DN_BIAS(C0, C1, t_); \
        const float shf = cb_cur - mfix; (void)shf; \
        SBAR(); \
        if (DV == 64) { \
            GAPB4(o[0] = MFMA32(PAF(0), vf[0], o[0]), C0, 0, -1); \
            GAPB4(o[1] = MFMA32(PAF(0), vf[1], o[1]), C0, 4, -1); \
            GAPB4(o[0] = MFMA32(PAF(1), vf[2], o[0]), C0, 8, 0); \
            GAPB4(o[1] = MFMA32(PAF(1), vf[3], o[1]), C0, 12, 1); \
            GAPB4(o[0] = MFMA32(PAF(2), vf[4], o[0]), C1, 0, 2); \
            GAPB4(o[1] = MFMA32(PAF(2), vf[5], o[1]), C1, 4, 3); \
            GAPB4(o[0] = MFMA32(PAF(3), vf[6], o[0]), C1, 8, -1); \
            if ((t_) + 3 < ntd) DN_DMA_K((t_) + 3, sl_cur); \
            GAPB4(o[1] = MFMA32(PAF(3), vf[7], o[1]), C1, 12, -1); \
            if ((t_) + 1 < ntd) DN_DMA_V((t_) + 1, sl_next); \
        } else { \
            GAPB2(o[0] = MFMA32(PAF(0), vf[0], o[0]), C0, 0,  DN_VFRAG(vf[0], Vs, 2, 0)); \
            GAPB2(o[1] = MFMA32(PAF(0), vf[1], o[1]), C0, 2,  DN_VFRAG(vf[1], Vs, 3, 0)); \
            GAPB2(o[0] = MFMA32(PAF(1), vf[2], o[0]), C0, 4,  DN_VFRAG(vf[2], Vs, 2, 1)); \
            GAPB2(o[1] = MFMA32(PAF(1), vf[3], o[1]), C0, 6,  DN_VFRAG(vf[3], Vs, 3, 1)); \
            GAPB2(o[0] = MFMA32(PAF(2), vf[4], o[0]), C0, 8,  DN_VFRAG(vf[4], Vs, 2, 2)); \
            GAPB2(o[1] = MFMA32(PAF(2), vf[5], o[1]), C0, 10, DN_VFRAG(vf[5], Vs, 3, 2)); \
            GAPB2(o[0] = MFMA32(PAF(3), vf[6], o[0]), C0, 12, DN_VFRAG(vf[6], Vs, 2, 3)); \
            GAPB2(o[1] = MFMA32(PAF(3), vf[7], o[1]), C0, 14, DN_VFRAG(vf[7], Vs, 3, 3)); \
            GAPB2(o[NDB - 2] = MFMA32(PAF(0), vf[0], o[NDB - 2]), C1, 0,  (void)0); \
            GAPB2(o[NDB - 1] = MFMA32(PAF(0), vf[1], o[NDB - 1]), C1, 2,  (void)0); \
            GAPB2(o[NDB - 2] = MFMA32(PAF(1), vf[2], o[NDB - 2]), C1, 4,  DN_KLOAD2(Kn, 0)); \
            GAPB2(o[NDB - 1] = MFMA32(PAF(1), vf[3], o[NDB - 1]), C1, 6,  DN_KLOAD2(Kn, 1)); \
            GAPB2(o[NDB - 2] = MFMA32(PAF(2), vf[4], o[NDB - 2]), C1, 8,  DN_KLOAD2(Kn, 2)); \
            GAPB2(o[NDB - 1] = MFMA32(PAF(2), vf[5], o[NDB - 1]), C1, 10, DN_KLOAD2(Kn, 3)); \
            GAPB2(o[NDB - 2] = MFMA32(PAF(3), vf[6], o[NDB - 2]), C1, 12, (void)0); \
            if ((t_) + 3 < ntd) DN_DMA_K((t_) + 3, sl_cur); \
            GAPB2(o[NDB - 1] = MFMA32(PAF(3), vf[7], o[NDB - 1]), C1, 14, (void)0); \
            if ((t_) + 1 < ntd) DN_DMA_V((t_) + 1, sl_next); \
        } \
        { const int pend = (((t_) + 3 < ntd) ? 1 : 0) + (((t_) + 1 < ntd) ? NVP : 0); \
          if (pend >= 3) asm volatile("s_waitcnt vmcnt(3) lgkmcnt(0)" ::: "memory"); \
          else if (pend == 2) asm volatile("s_waitcnt vmcnt(2) lgkmcnt(0)" ::: "memory"); \
          else if (pend == 1) asm volatile("s_waitcnt vmcnt(1) lgkmcnt(0)" ::: "memory"); \
          else asm volatile("s_waitcnt vmcnt(0) lgkmcnt(0)" ::: "memory"); } \
        if (!res) __builtin_amdgcn_s_barrier(); \
        asm volatile("" ::: "memory"); \
        { const int tmp = sl_prev; sl_prev = sl_cur; sl_cur = sl_next; sl_next = res ? sl_next + 1 : tmp; } \
    } while (0)
    int t = 1;
    for (; t + 1 < nt; t += 2) { DN_STEP(pA0, pA1, pB0, pB1, t); DN_STEP(pB0, pB1, pA0, pA1, t + 1); }
#define DN_DRAIN(X0, X1) do { \
        const LAS unsigned char* Vs = lds + A_Vx + sl_prev * VSLOT + voff; \
        float sacc = 0.f; \
        _Pragma("unroll") for (int r = 0; r < 16; ++r) sacc += X0[r] + X1[r]; \
        l_run += sacc; \
        pw0 = (u32x4){PKW(X0, 0), PKW(X0, 2), PKW(X0, 4), PKW(X0, 6)}; pw1 = (u32x4){PKW(X0, 8), PKW(X0, 10), PKW(X0, 12), PKW(X0, 14)}; \
        pw2 = (u32x4){PKW(X1, 0), PKW(X1, 2), PKW(X1, 4), PKW(X1, 6)}; pw3 = (u32x4){PKW(X1, 8), PKW(X1, 10), PKW(X1, 12), PKW(X1, 14)}; \
        _Pragma("unroll") for (int dh = 0; dh < NDB / 2; ++dh) { \
            bf16x8 vf[8]; \
            _Pragma("unroll") for (int i = 0; i < 8; ++i) DN_VFRAG(vf[i], Vs, 2 * dh + (i & 1), i >> 1); \
            o[2 * dh] = MFMA32(PAF(0), vf[0], o[2 * dh]); o[2 * dh + 1] = MFMA32(PAF(0), vf[1], o[2 * dh + 1]); \
            o[2 * dh] = MFMA32(PAF(1), vf[2], o[2 * dh]); o[2 * dh + 1] = MFMA32(PAF(1), vf[3], o[2 * dh + 1]); \
            o[2 * dh] = MFMA32(PAF(2), vf[4], o[2 * dh]); o[2 * dh + 1] = MFMA32(PAF(2), vf[5], o[2 * dh + 1]); \
            o[2 * dh] = MFMA32(PAF(3), vf[6], o[2 * dh]); o[2 * dh + 1] = MFMA32(PAF(3), vf[7], o[2 * dh + 1]); \
        } } while (0)
    if (MODE == 2 && res && (nt & 1)) {
        __builtin_amdgcn_s_setprio(0);
        DN_DRAIN(pA0, pA1);
    } else {
        DN_STEP(pA0, pA1, pB0, pB1, t);
        __builtin_amdgcn_s_setprio(0);
        DN_DRAIN(pB0, pB1);
    }
#undef DN_DRAIN
#undef DN_STEP
#undef GAPA
#undef GAPB4
#undef GAPB2
#undef PAF
#undef DN_SETCB
#undef CINIT
#undef SBAR
#undef PIN
#undef EX2
#undef MFMA32
#undef DN_DMA_K
#undef DN_DMA_V
#undef DN_KLOAD2
#undef DN_VFRAG
#undef DN_KIND
#undef DN_BIAS
#undef MX3
#undef DN_ROWMAX
#undef PKW
    float lt = l_run + __shfl_xor(l_run, 32);
    if (MODE == 2 && u.has_sink) lt += __builtin_amdgcn_exp2f(((const LAS float*)(lds + MISC_OFF))[100 + u.sink4 + gh] - mfix);
    const float inv = 1.0f / lt;
    if (MODE == 2 && u.lse && hi == 0) u.lse[(long)(qw + r32) * u.lrs] = mfix + __builtin_amdgcn_logf(lt);
    if (hi == 0) wsf[32 + r32] = inv;
    asm volatile("s_waitcnt lgkmcnt(0)" ::: "memory");
#pragma unroll
    for (int r = 0; r < 16; ++r) {
        const int qi = crow(r, hi); const float f = wsf[32 + qi];
        { bf16* op = (bf16*)u.o + (long)(qw + qi) * u.ors + r32 + 64 * gh;
#pragma unroll
            for (int db = 0; db < NDB; ++db) op[db * 32] = (bf16)(cvtpk(o[db][r] * f, 0.f) & 0xffffu); }
    }
    asm volatile("s_waitcnt vmcnt(0) lgkmcnt(0)" ::: "memory");
    __builtin_amdgcn_s_barrier();
    asm volatile("" ::: "memory");
}
}

__device__ __forceinline__ float bias_max(const float* __restrict__ relpos, int col) {
    int ln = threadIdx.x & 31; asm volatile("" : "+v"(ln)); float bm = relpos[ln * 20 + col] * LOG2E;
#pragma unroll
    for (int o = 1; o < 32; o <<= 1) bm = fmaxf(bm, __shfl_xor(bm, o));
    return bm;
}
__device__ __forceinline__ float qk_bound(const float* __restrict__ g) {
    int ln = threadIdx.x & 63; asm volatile("" : "+v"(ln)); float vq = fabsf(g[ln]), vk = fabsf(g[64 + ln]);
#pragma unroll
    for (int o = 1; o < 64; o <<= 1) { vq = fmaxf(vq, __shfl_xor(vq, o)); vk = fmaxf(vk, __shfl_xor(vk, o)); }
    return 64.0f * vq * vk * QSCALE * 1.001f;
}
struct Args { const float* in[17]; float* out; unsigned char* ws; int ph_lo, ph_hi; };
enum { I_XP = 0, I_XS, I_CP, I_CS, I_WMOD, I_BMOD, I_NMIX, I_NFFN, I_WIN, I_WOUT, I_QKG, I_SINK, I_RELPOS, I_DLAM, I_DSUB, I_WGU, I_WDN };

template <int TYPE> __device__ __forceinline__ int srccol(int g0, int j) {
    if (TYPE == 0) return g0 + j;
    if (TYPE == 1) { const int n = j >> 4, fq = (j >> 2) & 3, i = j & 3; return (g0 & ~255) + 64 * ((g0 >> 5) & 3) + 32 * (fq & 1) + 16 * n + 8 * (fq >> 1) + 4 * ((g0 >> 7) & 1) + i; }
    if (TYPE == 3) return g0 + 8 * ((j >> 2) & 3) + 4 * (j >> 4) + (j & 3);
    const int pn = g0 >> 8, bj = (g0 >> 7) & 1, wc = (g0 >> 5) & 3, n = j >> 4, fq = (j >> 2) & 3, i = j & 3;
    return n * FF + 128 * pn + 32 * wc + 8 * fq + 4 * bj + i;
}
template <int TYPE> __device__ __forceinline__ void convert_item(const float* __restrict__ W, int N, int K, bf16* WT, int kb, int nb, LAS float* scr, int lane) {
    const int k0 = 64 * kb, g0 = 32 * nb;
    const int sc = srccol<TYPE>(g0, lane & 31);
#pragma unroll 8
    for (int i = 0; i < 32; ++i) { const int kk = 2 * i + (lane >> 5); scr[kk * 33 + (lane & 31)] = __builtin_nontemporal_load(W + (size_t)(k0 + kk) * N + sc); }
    asm volatile("s_waitcnt lgkmcnt(0)" ::: "memory");
    const int c = lane & 7;
#pragma unroll
    for (int j = 0; j < 4; ++j) { const int n = (lane >> 3) + 8 * j; const LAS float* s = scr + (8 * c) * 33 + n;
        u32x4 o; o.x = cvtpk(s[0 * 33], s[1 * 33]); o.y = cvtpk(s[2 * 33], s[3 * 33]); o.z = cvtpk(s[4 * 33], s[5 * 33]); o.w = cvtpk(s[6 * 33], s[7 * 33]);
        *(u32x4*)(WT + (size_t)(g0 + n) * K + k0 + 8 * c) = o; }
    asm volatile("s_waitcnt lgkmcnt(0)" ::: "memory");
}
__device__ __forceinline__ void sincos_pi4(double r, double& s, double& c) {
    const double r2 = r * r;
    s = r * (1.0 + r2 * (-1.0 / 6 + r2 * (1.0 / 120 + r2 * (-1.0 / 5040 + r2 * (1.0 / 362880 + r2 * (-1.0 / 39916800 + r2 * (1.0 / 6227020800.0)))))));
    c = 1.0 + r2 * (-0.5 + r2 * (1.0 / 24 + r2 * (-1.0 / 720 + r2 * (1.0 / 40320 + r2 * (-1.0 / 3628800 + r2 * (1.0 / 479001600 + r2 * (-1.0 / 87178291200.0)))))));
}

__global__ void __launch_bounds__(512, 2) mega_fwd(Args a) {
    extern __shared__ __attribute__((aligned(16))) unsigned char lds_raw[];
    LAS unsigned char* lds = (LAS unsigned char*)lds_raw;
    const int tid = threadIdx.x, lane = tid & 63, wave = __builtin_amdgcn_readfirstlane(tid >> 6);
    const int G = gridDim.x, bx = blockIdx.x, vcu = (G % 8 == 0) ? (bx % 8) * (G / 8) + bx / 8 : bx;
    const int gw = vcu * 8 + wave, NGW = G * 8;
    unsigned char* ws = a.ws;
    volatile LAS unsigned* MISC = (volatile LAS unsigned*)(lds + MISC_OFF);
    for (int i = tid; i < (LDS_BYTES - MISC_OFF) / 4; i += 512) ((LAS unsigned*)(lds + MISC_OFF))[i] = 0u;
    __syncthreads();
    { LAS float* tb = (LAS float*)(lds + MISC_OFF); LAS float* st = (LAS float*)lds;
      for (int i = tid; i < 640; i += 512) st[i] = a.in[I_RELPOS][i] * LOG2E;
      for (int j = wave; j < 4 * DEPTH; j += 8) { const float qb_ = qk_bound(a.in[I_QKG] + (j >> 2) * 512 + (j & 3) * 128); if (lane == 0) tb[64 + j] = qb_; }
      if (tid < 8 * DEPTH) tb[100 + tid] = a.in[I_SINK][tid] * LOG2E;
      __syncthreads();
      if (tid < 20) { float m_ = st[tid]; for (int b_ = 1; b_ < 32; ++b_) m_ = fmaxf(m_, st[b_ * 20 + tid]); tb[80 + tid] = m_; }
      __syncthreads(); }
    XcdBarrier bar = xcd_barrier_post((unsigned*)(ws + WS_CTL) + CW_BAR, MISC + 8);
    const int lo = a.ph_lo, hi_ = a.ph_hi;
#define IN(k) (lo <= (k) && (k) < hi_)
#define SEAM(k) do { if (IN(k) && IN((k) + 1)) xcd_barrier(bar); } while (0)

    float* mod = (float*)(ws + WS_MOD);
    float2* rope = (float2*)(ws + WS_ROPE);
    bf16* Win_t = (bf16*)(ws + WS_WIN); bf16* Wout_t = (bf16*)(ws + WS_WOUT); bf16* Wgu_t = (bf16*)(ws + WS_WGU); bf16* Wdn_t = (bf16*)(ws + WS_WDN);
    bf16* Hb = (bf16*)(ws + WS_H); bf16* QKV = (bf16*)(ws + WS_QKV); bf16* MIX = (bf16*)(ws + WS_MIX); bf16* ACT = (bf16*)(ws + WS_ACT);
    bf16* BSC = (bf16*)(ws + WS_BSC); float* BLSE = (float*)(ws + WS_BLSE); bf16* CSC = (bf16*)(ws + WS_CSC);
    float* X = a.out; bf16* XB = (bf16*)(ws + WS_XB);

    if (IN(0) && !SKIP_PRO) for (int rep = 0; rep < REP_PRO; ++rep) {
        int tid = threadIdx.x; asm volatile("" : "+v"(tid)); const int lane = tid & 63;
        const int gt = vcu * 512 + tid, NTH = G * 512;
        if (gt < 2048) {
            const float invf[16] = {1.f, 0.562341332f, 0.316227764f, 0.177827939f, 0.100000001f, 0.0562341325f, 0.0316227749f, 0.0177827943f, 0.00999999978f, 0.00562341325f, 0.00316227763f, 0.00177827943f, 0.00100000005f, 0.000562341302f, 0.000316227757f, 0.00017782794f};
            const int pos = gt >> 4, p = gt & 15;
            float fr = 1.f;
#pragma unroll
            for (int i = 0; i < 16; ++i) if (p == i) fr = invf[i];
            const float ang = (float)pos * fr;
            const double x = (double)ang; const double kq = __builtin_rint(x * 0.63661977236758134308);
            const double r = __builtin_fma(-kq, 6.123233995736766035868820147292e-17, __builtin_fma(-kq, 1.57079632679489661923, x));
            double s, c; sincos_pi4(r, s, c);
            const int qd = ((int)kq) & 3;
            const double cs = (qd == 0) ? c : (qd == 1) ? -s : (qd == 2) ? -c : s;
            const double sn = (qd == 0) ? s : (qd == 1) ? c : (qd == 2) ? -s : -c;
            rope[gt] = make_float2((float)cs, (float)sn);
        }
        { LAS float* sc = (LAS float*)lds; LAS float* red = (LAS float*)(lds + 40960);
          for (int i = tid; i < NSEQ * DM; i += 512) { const int b = i >> 11, k = i & (DM - 1); const float c = (b < 4) ? a.in[I_CP][b * DM + k] : a.in[I_CS][k]; sc[i] = c / (1.0f + __expf(-c)); }
          __syncthreads();
          const int cg = tid & 15, kg = tid >> 4;
          for (int item = bx; item < DEPTH * 192; item += G) {
              const int l = item / 192, n0 = (item % 192) * 64;
              const float* w = a.in[I_WMOD] + (size_t)l * DM * NMOD + n0 + cg * 4;
              f32x4 acc[NSEQ];
#pragma unroll
              for (int b = 0; b < NSEQ; ++b) acc[b] = (f32x4){0.f, 0.f, 0.f, 0.f};
#pragma unroll 8
              for (int i = 0; i < 64; ++i) { const int k = kg + 32 * i; const f32x4 wv = __builtin_nontemporal_load((const f32x4*)(w + (size_t)k * NMOD));
#pragma unroll
                  for (int b = 0; b < NSEQ; ++b) acc[b] = acc[b] + wv * sc[b * DM + k]; }
#pragma unroll
              for (int b = 0; b < NSEQ; ++b) *(LAS f32x4*)(red + (kg * NSEQ + b) * 64 + cg * 4) = acc[b];
              __syncthreads();
              if (tid < NSEQ * 64) { const int b = tid >> 6, n = tid & 63; float s = 0.f;
#pragma unroll 8
                  for (int k2 = 0; k2 < 32; ++k2) s += red[(k2 * NSEQ + b) * 64 + n];
                  float mv = s + a.in[I_BMOD][l * NMOD + n0 + n]; const int col = n0 + n, jj = col >> 11;
                  if (jj == 1) mv = (mv + 1.0f) * a.in[I_NMIX][l * DM + (col & (DM - 1))]; else if (jj == 4) mv = (mv + 1.0f) * a.in[I_NFFN][l * DM + (col & (DM - 1))];
                  mod[(size_t)(l * NSEQ + b) * NMOD + col] = mv; }
              __syncthreads();
          } }
            __syncthreads();
        { LAS float* scr = (LAS float*)(lds + wave * 8448);
          constexpr int I_IN = 32 * 144, I_OUT = 32 * 64, I_GU = 32 * 352, I_DN = 88 * 64, I_L = I_IN + I_OUT + I_GU + I_DN;
          for (int it = gw; it < DEPTH * I_L; it += NGW) {
              const int l = it / I_L; int r = it % I_L;
              if (r < I_IN) { convert_item<1>(a.in[I_WIN] + (size_t)l * DM * INW, INW, DM, Win_t + (size_t)l * INW * DM, r / 144, r % 144, scr, lane); continue; } r -= I_IN;
              if (r < I_OUT) { convert_item<3>(a.in[I_WOUT] + (size_t)l * DM * DM, DM, DM, Wout_t + (size_t)l * DM * DM, r / 64, r % 64, scr, lane); continue; } r -= I_OUT;
              if (r < I_GU) { convert_item<2>(a.in[I_WGU] + (size_t)l * DM * 2 * FF, 2 * FF, DM, Wgu_t + (size_t)l * 2 * FF * DM, r / 352, r % 352, scr, lane); continue; } r -= I_GU;
              convert_item<3>(a.in[I_WDN] + (size_t)l * FF * DM, DM, FF, Wdn_t + (size_t)l * DM * FF, r / 64, r % 64, scr, lane);
          } }
}
    SEAM(0);

    for (int l = 0; l < DEPTH; ++l) {
        const int p0 = 1 + 8 * l;
        const float* modl = mod + (size_t)l * NSEQ * NMOD;
#define NORM_PHASE(WHICH) do { \
            int lane = threadIdx.x & 63; asm volatile("" : "+v"(lane)); \
            const bool f32src = (l == 0 && !(WHICH)); \
            _Pragma("unroll 1") for (int r = gw; r < M; r += NGW) { \
                const int b = seq_of_row(r); \
                const float* sv = modl + (size_t)b * NMOD + ((WHICH) ? 3 : 0) * DM; const float* cv = sv + DM; \
                f32x4 v[4][2]; float ss = 0.f; \
                if (f32src) { const float* xr = ((r < MP) ? a.in[I_XP] + (size_t)r * DM : a.in[I_XS] + (size_t)(r - MP) * DM) + lane * 8; \
                    _Pragma("unroll") for (int j = 0; j < 4; ++j) { v[j][0] = *(const f32x4*)(xr + 512 * j); v[j][1] = *(const f32x4*)(xr + 512 * j + 4); } } \
                else { const bf16* xr = XB + (size_t)r * DM + lane * 8; \
                    _Pragma("unroll") for (int j = 0; j < 4; ++j) { const u32x4 w = __builtin_nontemporal_load((const u32x4*)(xr + 512 * j)); \
                        v[j][0] = (f32x4){__uint_as_float(w.x << 16), __uint_as_float(w.x & 0xffff0000u), __uint_as_float(w.y << 16), __uint_as_float(w.y & 0xffff0000u)}; \
                        v[j][1] = (f32x4){__uint_as_float(w.z << 16), __uint_as_float(w.z & 0xffff0000u), __uint_as_float(w.w << 16), __uint_as_float(w.w & 0xffff0000u)}; } } \
                _Pragma("unroll") for (int j = 0; j < 4; ++j) _Pragma("unroll") for (int h2 = 0; h2 < 2; ++h2) ss += (v[j][h2][0] * v[j][h2][0] + v[j][h2][1] * v[j][h2][1]) + (v[j][h2][2] * v[j][h2][2] + v[j][h2][3] * v[j][h2][3]); \
                const float rstd = 1.0f / sqrtf(wave_sum(ss) * (1.0f / DM) + 1e-6f); \
                bf16* orow = Hb + (size_t)r * DM + lane * 8; \
                _Pragma("unroll") for (int j = 0; j < 4; ++j) { f32x4 y[2]; \
                    _Pragma("unroll") for (int h2 = 0; h2 < 2; ++h2) { const int e = 512 * j + lane * 8 + 4 * h2; const f32x4 c4 = *(const f32x4*)(cv + e), s4 = *(const f32x4*)(sv + e); \
                        y[h2] = v[j][h2] * rstd * c4 + s4; } \
                    u32x4 w; w.x = cvtpk(y[0][0], y[0][1]); w.y = cvtpk(y[0][2], y[0][3]); w.z = cvtpk(y[1][0], y[1][1]); w.w = cvtpk(y[1][2], y[1][3]); *(u32x4*)(orow + 512 * j) = w; } \
            } } while (0)
        if (IN(p0) && !SKIP_NORM) { for (int rep = 0; rep < REP_NORM; ++rep) NORM_PHASE(0); }
        SEAM(p0);
        if (IN(p0 + 1) && !SKIP_GIN) for (int rep = 0; rep < REP_GIN; ++rep) {
            pg8::Gemm g{Hb, Win_t + (size_t)l * INW * DM, M, INW, DM}; pg8::StaticOrder S; S.init(M, INW, G, bx);
            pg8::EpiQKV E{QKV, a.in[I_QKG] + l * 512, rope};
            pg8::gemm_phase<pg8::EpiQKV>(lds, g, S, E);
        }
        SEAM(p0 + 1);
        if (IN(p0 + 2) && !SKIP_ATT) for (int rep = 0; rep < (ATT_REP_MASK ? 2 : REP_ATT); ++rep) {
            const float* relpos = a.in[I_RELPOS];
            const int NU = 4608;
#define QKB(mx) (((const LAS float*)(lds + MISC_OFF))[64 + 4 * l + (mx)])
#define BIASMAX(col) (((const LAS float*)(lds + MISC_OFF))[80 + (col)])
            for (int U = vcu; U < NU; U += G) {
                if (ATT_REP_MASK && rep == 1) { const int cls = (U < 1536) ? (((U < 256) || (U >= 512 && U < 1024)) ? 1 : 2) : (U < 2304 ? 4 : 8); if (!(ATT_REP_MASK & cls)) continue; }
                att::AU u; u.res = 0; u.mfix = 0.f; u.rs = INW; u.lse = nullptr; u.lrs = 0; u.sink4 = 0; u.has_sink = 0; u.wsh = 3; u.W = 0; u.hcol = 0; u.rmul = 1; u.of32 = 0;
                if (U < 1536) {
                    int s, hh, qb, isC;
                    if (U < 256) { isC = 1; s = 4; hh = U >> 5; qb = U & 31; }
                    else if (U < 512) { const int i = U - 256; isC = 0; s = 4; hh = i >> 5; qb = i & 31; }
                    else if (U < 1024) { const int i = U - 512; isC = 1; s = i >> 7; hh = (i >> 4) & 7; qb = i & 15; }
                    else { const int i = U - 1024; isC = 0; s = i >> 7; hh = (i >> 4) & 7; qb = i & 15; }
                    const int rb = (s < 4) ? s * TP : MP, T = (s < 4) ? TP : TS;
                    const bf16* base = QKV + (size_t)rb * INW;
                    u.q0 = qb * 256; u.kv0 = 0; u.nt = T / 64;
                    if (isC) { u.q = base + C_QC + 64 * hh; u.k = base + C_KC + 64 * hh; u.v = base + C_VC + 128 * (hh >> 1); u.hcol = 16 + (hh >> 1);
                               u.o = CSC + ((size_t)rb * 8 + hh) * 128; u.ors = 1024; u.mfix = QKB(2) + BIASMAX(16 + (hh >> 1)); att::attn_dense<1>(u, lds, relpos); }
                    else { u.q = base + C_QD + 64 * hh; u.k = base + C_KD + 64 * (hh >> 2); u.v = base + C_VD + 64 * (hh >> 2);
                           u.o = MIX + (size_t)rb * DM + 1536 + 64 * hh; u.ors = DM; u.mfix = QKB(3); att::attn_dense<0>(u, lds, relpos); }
                } else if (U < 2304) {
                    const int i = U - 1536; int s, kvh, qb;
                    if (i < 512) { s = i >> 7; kvh = (i >> 6) & 1; qb = i & 63; } else { const int i2 = i - 512; s = 4; kvh = i2 >> 7; qb = i2 & 127; }
                    const int rb = (s < 4) ? s * TP : MP, T = (s < 4) ? TP : TS;
                    const bf16* base = QKV + (size_t)rb * INW;
                    u.q = base + C_QA + 256 * kvh; u.k = base + C_KA + 64 * kvh; u.v = base + C_VA + 64 * kvh;
                    u.q0 = qb * 64; u.W = 128; u.hcol = 4 * kvh; u.rmul = 1; u.wsh = 1;
                    int k0 = u.q0 - 128, k1 = u.q0 + 192; if (k0 < 0) k0 = 0; if (k1 > T) k1 = T;
                    if (((k1 - k0) >> 6) & 1) { if (k1 + 64 <= T) k1 += 64; else k0 -= 64; }
                    u.kv0 = k0; u.nt = (k1 - k0) / 64; u.res = u.nt < 5 ? u.nt : 5;
                    u.o = MIX + (size_t)rb * DM + 256 * kvh; u.ors = DM;
                    u.sink4 = 8 * l + 4 * kvh; u.has_sink = 1;
                    u.mfix = QKB(0) + fmaxf(fmaxf(BIASMAX(4 * kvh), BIASMAX(4 * kvh + 1)), fmaxf(BIASMAX(4 * kvh + 2), BIASMAX(4 * kvh + 3)));
                    att::attn_dense<2>(u, lds, relpos);
                } else {
                    const int i = U - 2304; const int pat = i / 768, rem = i % 768, hh = rem / 96, r2 = rem % 96;
                    const int rr = (pat == 0) ? 1 : (pat == 1) ? 4 : 16;
                    int s, rho, qb;
                    if (r2 < 64) { s = r2 >> 4; const int w = r2 & 15, nb = 16 / rr; rho = w / nb; qb = w % nb; }
                    else { s = 4; const int w = r2 - 64, nb = 32 / rr; rho = w / nb; qb = w % nb; }
                    const int rb = (s < 4) ? s * TP : MP, T = (s < 4) ? TP : TS, L = T / rr;
                    const bf16* base = QKV + (size_t)(rb + rho) * INW;
                    u.q = base + C_QB + 64 * hh; u.k = base + C_KB + 64 * hh; u.v = base + C_VB + 64 * hh; u.rs = (long)rr * INW;
                    u.q0 = qb * 256; u.W = 64; u.hcol = 8 + hh; u.rmul = rr; u.wsh = 3; u.res = 3;
                    int k0 = u.q0 - 64, k1 = u.q0 + 320; if (k0 < 0) k0 = 0; if (k1 > L) k1 = L;
                    if (((k1 - k0) >> 6) & 1) { if (k1 + 64 <= L) k1 += 64; else k0 -= 64; }
                    u.kv0 = k0; u.nt = (k1 - k0) / 64;
                    u.o = BSC + ((size_t)pat * M + rb + rho) * 512 + 64 * hh; u.ors = (long)rr * 512;
                    u.lse = BLSE + ((size_t)pat * M + rb + rho) * 8 + hh; u.lrs = (long)rr * 8;
                    u.mfix = QKB(1) + BIASMAX(8 + hh);
                    att::attn_dense<2>(u, lds, relpos);
                }
            }
        }
        SEAM(p0 + 2);
        if (IN(p0 + 3) && !SKIP_CMB) for (int rep = 0; rep < REP_CMB; ++rep) {
            int lane = threadIdx.x & 63; asm volatile("" : "+v"(lane));
            const float lam_init = 0.8f - 0.6f * expf(-0.3f * (float)l);
            const float* dl = a.in[I_DLAM] + l * 256;
            const float s1 = wave_sum(dl[lane] * dl[64 + lane]), s2 = wave_sum(dl[128 + lane] * dl[192 + lane]);
            const float lam = expf(s1) - expf(s2) + lam_init;
            const float* sub = a.in[I_DSUB] + l * 128;
            const int hC = lane >> 4, dC = (lane & 15) * 8, hB = lane >> 3, dB = (lane & 7) * 8;
            const f32x4 sg0 = *(const f32x4*)(sub + dC) * (1.0f - lam_init), sg1 = *(const f32x4*)(sub + dC + 4) * (1.0f - lam_init);
            for (int r = gw; r < M; r += NGW) {
                { const bf16* p0_ = CSC + ((size_t)r * 8 + hC * 2) * 128 + dC; const u32x4 w0 = __builtin_nontemporal_load((const u32x4*)p0_), w1 = __builtin_nontemporal_load((const u32x4*)(p0_ + 128));
                  float a[8];
#pragma unroll
                  for (int j = 0; j < 4; ++j) { a[2 * j] = __uint_as_float(w0[j] << 16) - lam * __uint_as_float(w1[j] << 16); a[2 * j + 1] = __uint_as_float(w0[j] & 0xffff0000u) - lam * __uint_as_float(w1[j] & 0xffff0000u); }
                  float ss = 0.f;
#pragma unroll
                  for (int j = 0; j < 8; ++j) ss += a[j] * a[j];
                  ss += __shfl_xor(ss, 1); ss += __shfl_xor(ss, 2); ss += __shfl_xor(ss, 4); ss += __shfl_xor(ss, 8);
                  const float rstd = 1.0f / sqrtf(ss * (1.0f / 128.0f) + 1e-6f);
                  u32x4 w; w.x = cvtpk(a[0] * rstd * sg0[0], a[1] * rstd * sg0[1]); w.y = cvtpk(a[2] * rstd * sg0[2], a[3] * rstd * sg0[3]);
                  w.z = cvtpk(a[4] * rstd * sg1[0], a[5] * rstd * sg1[1]); w.w = cvtpk(a[6] * rstd * sg1[2], a[7] * rstd * sg1[3]);
                  *(u32x4*)(MIX + (size_t)r * DM + 1024 + hC * 128 + dC) = w; }
                { const float e0 = BLSE[((size_t)0 * M + r) * 8 + hB], e1 = BLSE[((size_t)1 * M + r) * 8 + hB], e2 = BLSE[((size_t)2 * M + r) * 8 + hB];
                  const float mx = fmaxf(e0, fmaxf(e1, e2));
                  float w0 = __builtin_amdgcn_exp2f(e0 - mx), w1 = __builtin_amdgcn_exp2f(e1 - mx), w2 = __builtin_amdgcn_exp2f(e2 - mx);
                  const float iw = 1.0f / (w0 + w1 + w2); w0 *= iw; w1 *= iw; w2 *= iw;
                  const u32x4 q0_ = __builtin_nontemporal_load((const u32x4*)(BSC + ((size_t)0 * M + r) * 512 + hB * 64 + dB)), q1_ = __builtin_nontemporal_load((const u32x4*)(BSC + ((size_t)1 * M + r) * 512 + hB * 64 + dB)), q2_ = __builtin_nontemporal_load((const u32x4*)(BSC + ((size_t)2 * M + r) * 512 + hB * 64 + dB));
                  u32x4 w;
#pragma unroll
                  for (int j = 0; j < 4; ++j) {
                      const float lo = __uint_as_float(q0_[j] << 16) * w0 + __uint_as_float(q1_[j] << 16) * w1 + __uint_as_float(q2_[j] << 16) * w2;
                      const float hi2 = __uint_as_float(q0_[j] & 0xffff0000u) * w0 + __uint_as_float(q1_[j] & 0xffff0000u) * w1 + __uint_as_float(q2_[j] & 0xffff0000u) * w2;
                      w[j] = cvtpk(lo, hi2); }
                  *(u32x4*)(MIX + (size_t)r * DM + 512 + hB * 64 + dB) = w; }
            }
        }
        SEAM(p0 + 3);
        if (IN(p0 + 4) && !SKIP_GOUT) for (int rep = 0; rep < REP_GRES; ++rep) {
            pg8::Gemm g{MIX, Wout_t + (size_t)l * DM * DM, M, DM, DM}; pg8::StaticOrder S; S.init(M, DM, G, bx);
            const int s32 = (l == 0 && rep == 0) ? 1 : 0;
            pg8::EpiResid E{XB, s32 ? (const void*)a.in[I_XP] : (const void*)XB, s32 ? (const void*)a.in[I_XS] : (const void*)(XB + (size_t)MP * DM), modl + 2 * DM, rep == 0 ? 1.0f : 0.0f, s32, 0, 0};
            pg8::gemm_phase<pg8::EpiResid>(lds, g, S, E);
        }
        SEAM(p0 + 4);
        if (IN(p0 + 5) && !SKIP_NORM) { for (int rep = 0; rep < REP_NORM; ++rep) NORM_PHASE(1); }
        SEAM(p0 + 5);
        if (IN(p0 + 6) && !SKIP_GGU) for (int rep = 0; rep < REP_GGU; ++rep) {
            pg8::Gemm g{Hb, Wgu_t + (size_t)l * 2 * FF * DM, M, 2 * FF, DM}; pg8::StaticOrder S; S.init(M, 2 * FF, G, bx);
            pg8::EpiSwiglu E{ACT};
            pg8::gemm_phase<pg8::EpiSwiglu>(lds, g, S, E);
        }
        SEAM(p0 + 6);
        if (IN(p0 + 7) && !SKIP_GDN) for (int rep = 0; rep < REP_GRES; ++rep) {
            pg8::Gemm g{ACT, Wdn_t + (size_t)l * DM * FF, M, DM, FF}; pg8::StaticOrder S; S.init(M, DM, G, bx);
            const int d32 = (l + 1 == DEPTH) ? 1 : 0;
            pg8::EpiResid E{d32 ? (void*)X : (void*)XB, XB, XB + (size_t)MP * DM, modl + 5 * DM, rep == 0 ? 1.0f : 0.0f, 0, d32, 0};
            pg8::gemm_phase<pg8::EpiResid>(lds, g, S, E);
        }
        SEAM(p0 + 7);
    }
#undef IN
#undef SEAM
#undef NORM_PHASE
}

extern "C" void kernel_launch(void* const* d_in, const int* in_sizes, int n_in, void* d_out, int out_size, void* d_ws, size_t ws_size, hipStream_t stream) {
    static int grid = 0;
    if (grid == 0) {
        if (n_in != 17 || out_size != M * DM || ws_size < WS_END) { fprintf(stderr, "kernel_launch: unexpected shapes (n_in %d out %d ws %zu)\n", n_in, out_size, ws_size); grid = -1; return; }
        int dev = 0, cus = 0, per_cu = 0;
        if (hipGetDevice(&dev) != hipSuccess || hipDeviceGetAttribute(&cus, hipDeviceAttributeMultiprocessorCount, dev) != hipSuccess) { grid = -1; return; }
        if (hipFuncSetAttribute((const void*)mega_fwd, hipFuncAttributeMaxDynamicSharedMemorySize, LDS_BYTES) != hipSuccess) { fprintf(stderr, "kernel_launch: hipFuncSetAttribute failed\n"); grid = -1; return; }
        if (hipOccupancyMaxActiveBlocksPerMultiprocessor(&per_cu, (const void*)mega_fwd, 512, LDS_BYTES) != hipSuccess || per_cu < 1) { fprintf(stderr, "kernel_launch: occupancy query says %d\n", per_cu); }
        (void)hipGetLastError();
        grid = cus;
    }
    if (grid < 0) return;
    (void)hipMemsetAsync((char*)d_ws + WS_CTL, 0, CTL_ZERO_BYTES, stream);
    Args a{};
    for (int i = 0; i < 17; ++i) a.in[i] = (const float*)d_in[i];
    a.out = (float*)d_out; a.ws = (unsigned char*)d_ws;
    const int NPH = 1 + 8 * DEPTH;
#if MK_PER_PHASE
    for (int p = 0; p < NPH; ++p) { a.ph_lo = p; a.ph_hi = p + 1; hipLaunchKernelGGL(mega_fwd, dim3(grid), dim3(512), LDS_BYTES, stream, a); }
#else
    a.ph_lo = 0; a.ph_hi = NPH;
    hipLaunchKernelGGL(mega_fwd, dim3(grid), dim3(512), LDS_BYTES, stream, a);
#endif
}
```
